# Optimizing an MI355X kernel written in HIP

```python
import math
import jax, jax.numpy as jnp
from jax import lax
import numpy as np

D_MODEL = 1024
BATCH = 8
SEQ = 2048
DEPTH = 4

N_EVEN = (DEPTH + 1) // 2
N_ODD = DEPTH // 2
EPS = 1e-6
NEG_INF = -1e30
Q_BLOCK = 128
FOX_WIDTH = D_MODEL // 2
FOX_HEAD_DIM = 64
FOX_HEADS = FOX_WIDTH // FOX_HEAD_DIM
SC_WIDTH = D_MODEL - FOX_WIDTH
SC_GROUPS = SC_WIDTH // 64
SC_K = 3
AB_IN = 3 * FOX_WIDTH + FOX_HEADS + 3 * SC_WIDTH
LRU_WIDTH = D_MODEL
LRU_BW = 256
LRU_BLOCKS = LRU_WIDTH // LRU_BW
RG_CONV_K = 4
RG_C = 8.0
RG_MIN_RAD = 0.9
RG_MAX_RAD = 0.999
MEM_LEN = 256
MEM_HEADS = 4
MEM_HEAD_DIM = D_MODEL // MEM_HEADS
D_FF = ((8 * D_MODEL // 3 + 255) // 256) * 256

kernel_name = "fox_shortconv_rglru_sandwich_hybrid"


def rmsnorm(x, g):
    x32 = x.astype(jnp.float32)
    y = x32 * lax.rsqrt(jnp.mean(x32 * x32, axis=-1, keepdims=True) + EPS)
    return y.astype(x.dtype) * g


def causal_depthwise_conv(x, w):
    k_width, ch = w.shape
    return lax.conv_general_dilated(
        x, w[:, None, :], window_strides=(1,), padding=[(k_width - 1, 0)],
        dimension_numbers=("NWC", "WIO", "NWC"), feature_group_count=ch)


def forgetting_attention(q, k, v, log_f):
    seq = q.shape[1]
    scale = q.shape[-1] ** -0.5
    cum = jnp.cumsum(log_f, axis=1).transpose(0, 2, 1)
    outs = []
    for blk in range(seq // Q_BLOCK):
        lo, hi = blk * Q_BLOCK, (blk + 1) * Q_BLOCK
        s = jnp.einsum("bqhd,bkhd->bhqk", q[:, lo:hi], k[:, :hi],
                       preferred_element_type=jnp.float32) * scale
        s = s + cum[:, :, lo:hi, None] - cum[:, :, None, :hi]
        causal = (lo + jnp.arange(Q_BLOCK))[:, None] >= jnp.arange(hi)[None, :]
        s = jnp.where(causal, s, NEG_INF)
        p = jax.nn.softmax(s, axis=-1).astype(v.dtype)
        outs.append(jnp.einsum("bhqk,bkhd->bqhd", p, v[:, :hi]))
    return jnp.concatenate(outs, axis=1)


def fox_shortconv_mixer(h, w_in, b_f, conv_w, w_out):
    bsz, seq, _ = h.shape
    proj = h @ w_in
    i1 = FOX_WIDTH
    i2 = 2 * FOX_WIDTH
    i3 = 3 * FOX_WIDTH
    i4 = i3 + FOX_HEADS
    i5 = i4 + SC_WIDTH
    i6 = i5 + SC_WIDTH
    q, k, v, f_logit, b_gate, c_gate, u = jnp.split(proj, [i1, i2, i3, i4, i5, i6], axis=-1)
    heads = lambda t: t.reshape(bsz, seq, FOX_HEADS, FOX_HEAD_DIM)
    log_f = jax.nn.log_sigmoid((f_logit + b_f).astype(jnp.float32))
    y_a = forgetting_attention(heads(q), heads(k), heads(v), log_f).reshape(bsz, seq, FOX_WIDTH)
    y_b = b_gate * causal_depthwise_conv(c_gate * u, conv_w)
    return jnp.concatenate([y_a, y_b], axis=-1) @ w_out


def _lru_combine(c1, c2):
    a1, b1 = c1
    a2, b2 = c2
    return a1 * a2, a2 * b1 + b2


def rglru_mixer(h, w_in, conv_w, conv_b, w_a, b_a, w_i, b_i, lam, w_out):
    bsz, seq, _ = h.shape
    gate, u = jnp.split(h @ w_in, 2, axis=-1)
    u = causal_depthwise_conv(u, conv_w) + conv_b
    ub = u.reshape(bsz, seq, LRU_BLOCKS, LRU_BW)
    r = jax.nn.sigmoid(jnp.einsum("bsnc,ncd->bsnd", ub, w_a) + b_a).reshape(bsz, seq, LRU_WIDTH)
    i = jax.nn.sigmoid(jnp.einsum("bsnc,ncd->bsnd", ub, w_i) + b_i).reshape(bsz, seq, LRU_WIDTH)
    log_a = -RG_C * r.astype(jnp.float32) * jax.nn.softplus(-lam.astype(jnp.float32))
    a = jnp.exp(log_a)
    b = jnp.sqrt(-jnp.expm1(2.0 * log_a)) * (i * u).astype(jnp.float32)
    _, hs = lax.associative_scan(_lru_combine, (a, b), axis=1)
    y = jax.nn.gelu(gate) * hs.astype(h.dtype)
    return y @ w_out


def memory_cross_attention(h, m, w_q, w_kv, w_o):
    bsz, seq, _ = h.shape
    mlen = m.shape[1]
    q = (h @ w_q).reshape(bsz, seq, MEM_HEADS, MEM_HEAD_DIM)
    k, v = jnp.split(m @ w_kv, 2, axis=-1)
    k = k.reshape(bsz, mlen, MEM_HEADS, MEM_HEAD_DIM)
    v = v.reshape(bsz, mlen, MEM_HEADS, MEM_HEAD_DIM)
    s = jnp.einsum("bqhd,bkhd->bhqk", q, k, preferred_element_type=jnp.float32) * (MEM_HEAD_DIM ** -0.5)
    p = jax.nn.softmax(s, axis=-1).astype(v.dtype)
    o = jnp.einsum("bhqk,bkhd->bqhd", p, v).reshape(bsz, seq, D_MODEL)
    return o @ w_o


def swiglu(h, w_gu, w_down):
    g, u = jnp.split(h @ w_gu, 2, axis=-1)
    return (jax.nn.silu(g) * u) @ w_down


def setup_inputs(seed: int = 0) -> dict:
    key = jax.random.key(seed)
    ks = iter(jax.random.split(key, 40))
    dense = lambda shape, fan_in: jax.random.normal(next(ks), shape, jnp.float32) * (fan_in ** -0.5)
    gain = lambda shape: 1.0 + 0.02 * jax.random.normal(next(ks), shape, jnp.float32)
    small = lambda shape: 0.01 * jax.random.normal(next(ks), shape, jnp.float32)
    x = jax.random.normal(next(ks), (BATCH, SEQ, D_MODEL), jnp.float32)
    mem = jax.random.normal(next(ks), (BATCH, MEM_LEN, D_MODEL), jnp.float32)
    rad = jax.random.uniform(next(ks), (N_ODD, LRU_WIDTH), jnp.float32, RG_MIN_RAD, RG_MAX_RAD)
    c_lam = -jnp.log(jnp.expm1(-jnp.log(rad) / RG_C))
    return {
        "x": x,
        "mem": mem,
        "g_mix_pre": gain((DEPTH, D_MODEL)),
        "g_mix_post": gain((DEPTH, D_MODEL)),
        "g_cross_pre": gain((DEPTH, D_MODEL)),
        "g_mem": gain((DEPTH, D_MODEL)),
        "g_cross_post": gain((DEPTH, D_MODEL)),
        "g_ffn_pre": gain((DEPTH, D_MODEL)),
        "g_ffn_post": gain((DEPTH, D_MODEL)),
        "w_xq": dense((DEPTH, D_MODEL, D_MODEL), D_MODEL),
        "w_xkv": dense((DEPTH, D_MODEL, 2 * D_MODEL), D_MODEL),
        "w_xo": dense((DEPTH, D_MODEL, D_MODEL), D_MODEL),
        "w_ffn_gu": dense((DEPTH, D_MODEL, 2 * D_FF), D_MODEL),
        "w_ffn_down": dense((DEPTH, D_FF, D_MODEL), D_FF),
        "ab_w_in": dense((N_EVEN, D_MODEL, AB_IN), D_MODEL),
        "ab_b_f": jax.random.uniform(next(ks), (N_EVEN, FOX_HEADS), jnp.float32, 2.0, 5.0),
        "ab_conv_w": dense((N_EVEN, SC_K, SC_WIDTH), SC_K),
        "ab_w_out": dense((N_EVEN, D_MODEL, D_MODEL), D_MODEL),
        "c_w_in": dense((N_ODD, D_MODEL, 2 * LRU_WIDTH), D_MODEL),
        "c_conv_w": dense((N_ODD, RG_CONV_K, LRU_WIDTH), RG_CONV_K),
        "c_conv_b": small((N_ODD, LRU_WIDTH)),
        "c_w_a": dense((N_ODD, LRU_BLOCKS, LRU_BW, LRU_BW), LRU_BW),
        "c_b_a": small((N_ODD, LRU_BLOCKS, LRU_BW)),
        "c_w_i": dense((N_ODD, LRU_BLOCKS, LRU_BW, LRU_BW), LRU_BW),
        "c_b_i": small((N_ODD, LRU_BLOCKS, LRU_BW)),
        "c_lam": c_lam,
        "c_w_out": dense((N_ODD, LRU_WIDTH, D_MODEL), LRU_WIDTH),
    }


def reference(x, mem, g_mix_pre, g_mix_post, g_cross_pre, g_mem, g_cross_post,
              g_ffn_pre, g_ffn_post, w_xq, w_xkv, w_xo, w_ffn_gu, w_ffn_down,
              ab_w_in, ab_b_f, ab_conv_w, ab_w_out,
              c_w_in, c_conv_w, c_conv_b, c_w_a, c_b_a, c_w_i, c_b_i, c_lam, c_w_out):
    for layer in range(DEPTH):
        h = rmsnorm(x, g_mix_pre[layer])
        if layer % 2 == 0:
            e = layer // 2
            y = fox_shortconv_mixer(h, ab_w_in[e], ab_b_f[e], ab_conv_w[e], ab_w_out[e])
        else:
            o = layer // 2
            y = rglru_mixer(h, c_w_in[o], c_conv_w[o], c_conv_b[o], c_w_a[o], c_b_a[o],
                            c_w_i[o], c_b_i[o], c_lam[o], c_w_out[o])
        x = x + rmsnorm(y, g_mix_post[layer])
        h = rmsnorm(x, g_cross_pre[layer])
        m = rmsnorm(mem, g_mem[layer])
        y = memory_cross_attention(h, m, w_xq[layer], w_xkv[layer], w_xo[layer])
        x = x + rmsnorm(y, g_cross_post[layer])
        h = rmsnorm(x, g_ffn_pre[layer])
        y = swiglu(h, w_ffn_gu[layer], w_ffn_down[layer])
        x = x + rmsnorm(y, g_ffn_post[layer])
    return x
```

```cpp
#include <hip/hip_runtime.h>
#include <hip/hip_cooperative_groups.h>
#include <cstdio>
#include <cstdint>
namespace cg = cooperative_groups;
#ifndef N_LAUNCH_PER_PHASE
#define N_LAUNCH_PER_PHASE 0
#endif
constexpr int DM = 1024, SEQ = 2048, NB = 8, MT = NB * SEQ  , DFF = 2816, MEML = 256;
constexpr float EPS = 1e-6f, LOG2E = 1.4426950408889634f;
constexpr size_t MiB = 1u << 20;
constexpr size_t WS_WQ = 0 * MiB, WS_WK = 8 * MiB, WS_WVT = 16 * MiB, WS_WO = 24 * MiB, WS_WGU = 32 * MiB, WS_WDN = 76 * MiB, WS_WIN = 98 * MiB, WS_WV = 108 * MiB,
                 WS_WOUT = 110 * MiB, WS_CIN = 114 * MiB, WS_CG = 122 * MiB, WS_COUT = 124 * MiB, WS_MEMK = 128 * MiB, WS_MEMVT = 144 * MiB, WS_H = 160 * MiB,
                 WS_PROJ = 192 * MiB, WS_Y = 288 * MiB, WS_LOGF = 320 * MiB, WS_WF = 320 * MiB + 512 * 1024, WS_SP = WS_WF + 65536, WS_END = 321 * MiB;
constexpr int LDS_BYTES = 147456;
constexpr int NPHASE = 49;

namespace pg8 {
#define PG8_LAS __attribute__((address_space(3)))
typedef unsigned short bf16_t;
typedef short bf16x8 __attribute__((ext_vector_type(8)));
typedef float f32x4 __attribute__((ext_vector_type(4)));
typedef unsigned u32x4 __attribute__((ext_vector_type(4)));
constexpr int BM = 256, BK = 64, HALF = 128, HTB = HALF * BK * 2  , STAGE_BYTES = 8 * HTB, NXCD = 8, WGM = 8;

__host__ __device__ __forceinline__ int lds_byte(int r, int c) { const int st = (r >> 4) * 2 + (c >> 5), rr = r & 15, cc = c & 31, ob = rr * 64 + cc * 2; return st * 1024 + (ob ^ (((ob >> 9) & 1) << 5)); }
__host__ __device__ __forceinline__ void stage_rc(int b, int& R, int& C) { const int st = b / 1024, sb = b % 1024, swz = sb ^ (((sb >> 9) & 1) << 5); R = (st >> 1) * 16 + swz / 64; C = (st & 1) * 32 + (swz % 64) / 2; }
__host__ __device__ __forceinline__ int perm32(int rho) { const int n = rho >> 4, i = rho & 15; return 8 * (i >> 2) + 4 * n + (i & 3); }

struct Unit { int pm, pn; };
struct Gemm { const bf16_t* A; const bf16_t* Bt; int M, N, K; };

struct StaticOrder {
    int nM, nN, nwg, G, c;
    __host__ __device__ void init(int M, int N, int G_, int c_) { nM = M / BM; nN = N / BM; nwg = nM * nN; G = G_; c = c_; }
    __host__ __device__ bool next(int i, Unit& u) const {
        const long L = (long)i * G + c; if (L >= nwg) return false;
        int wgid = (int)L; { const int q = nwg / NXCD, r = nwg % NXCD, xcd = wgid % NXCD, off = wgid / NXCD; wgid = (xcd < r ? xcd * (q + 1) : r * (q + 1) + (xcd - r) * q) + off; }
        const int nig = WGM * nN, gid = wgid / nig, fm = gid * WGM, gsz = (nM - fm) < WGM ? (nM - fm) : WGM;
        u.pm = fm + ((wgid % nig) % gsz); u.pn = (wgid % nig) / gsz; return true;
    }
    __device__ __forceinline__ void a_ready(const Unit&) const {}
    __device__ __forceinline__ void done(const Unit&) const {}
};

__device__ __forceinline__ unsigned cvt_pk_bf16(float lo, float hi) { unsigned r; asm volatile("v_cvt_pk_bf16_f32 %0, %1, %2" : "=v"(r) : "v"(lo), "v"(hi)); return r; }
typedef float f32x2 __attribute__((ext_vector_type(2)));
__device__ __forceinline__ u32x4 pack8(const f32x4 v0, const f32x4 v1) { u32x4 w; w.x = cvt_pk_bf16(v0[0], v0[1]); w.y = cvt_pk_bf16(v0[2], v0[3]); w.z = cvt_pk_bf16(v1[0], v1[1]); w.w = cvt_pk_bf16(v1[2], v1[3]); return w; }
__device__ __forceinline__ void store_tile_bf16(const f32x4 (&acc)[2][2][4][2], bf16_t* tile, size_t ldc, int wr, int wc, int fr, int fq) {
#pragma unroll
    for (int ai = 0; ai < 2; ++ai)
#pragma unroll
        for (int m = 0; m < 4; ++m) { bf16_t* rowp = tile + (size_t)(ai * HALF + wr * 64 + m * 16 + fr) * ldc + wc * 32 + 8 * fq;
#pragma unroll
            for (int bj = 0; bj < 2; ++bj) *(u32x4*)(rowp + bj * HALF) = pack8(acc[ai][bj][m][0], acc[ai][bj][m][1]); }
}
constexpr int GenOrder_tA = (int)(WS_Y / (512 * 1024)), GenOrder_tB = (int)(WS_WK / (512 * 1024)), GenOrder_tC = (int)(WS_WVT / (512 * 1024));
struct EpiAll {
    static constexpr bool PERM = true, AFTER_DRAIN = false;
    int mode; bf16_t* O; int ldc;
    __device__ __forceinline__ void operator()(const f32x4 (&acc)[2][2][4][2], const Unit& u, int, int, int, int) const {
        int t_ = threadIdx.x; asm volatile("" : "+v"(t_));
        const int wid_ = t_ >> 6, wr = wid_ >> 2, wc = wid_ & 3, fr = t_ & 15, fq = (t_ & 63) >> 4;
        if (mode <= 1) {
            bf16_t* base = O; size_t ld = (size_t)ldc; int om = u.pm, on = u.pn;
            if (mode == 1) { if (u.pm >= GenOrder_tA) { const int t = u.pm - GenOrder_tA; base += (size_t)(t >> 3) * 2048 * 1024; ld = 1024; om = t & 7; on = (u.pn - GenOrder_tB) & 3; }
                             else { const int t = u.pm - GenOrder_tC; base += (size_t)8 * 1024 * 1024 + (size_t)(t >> 2) * 2048 * 1024; ld = 2048; om = t & 3; on = (u.pn - GenOrder_tA) & 7; } }
            store_tile_bf16(acc, base + (size_t)om * BM * ld + (size_t)on * BM, ld, wr, wc, fr, fq);
        } else if (mode == 2) {
            bf16_t* tile = O + (size_t)u.pm * BM * ldc + (size_t)u.pn * HALF;
#pragma unroll
            for (int ai = 0; ai < 2; ++ai)
#pragma unroll
                for (int m = 0; m < 4; ++m) { bf16_t* rowp = tile + (size_t)(ai * HALF + wr * 64 + m * 16 + fr) * ldc + wc * 32 + 8 * fq;
                    f32x4 o[2];
#pragma unroll
                    for (int n = 0; n < 2; ++n)
#pragma unroll
                        for (int e = 0; e < 4; ++e) { const float g = acc[ai][0][m][n][e], up = acc[ai][1][m][n][e]; o[n][e] = g * __builtin_amdgcn_rcpf(1.0f + __expf(-g)) * up; }
                    *(u32x4*)rowp = pack8(o[0], o[1]); }
        } else {
            const int om = u.pm & 63;
            const int col0 = u.pn * HALF + wc * 32 + 8 * fq;
            const bf16_t* ucp = O + (size_t)16384 * 2048 - 1024 + ((size_t)(col0 >> 8) * 16384 + (size_t)om * BM + wr * 64 + fr) * 256 + (col0 & 255);
            bf16_t* bbp = (bf16_t*)((unsigned char*)O - 2048 - (WS_PROJ - WS_H)) + ((size_t)om * BM + wr * 64 + fr) * 1024 + col0;
            bf16_t* lap = O + ((size_t)om * BM + wr * 64 + fr) * 2048 + col0;
            const float* F = (const float*)((unsigned char*)O - 2048 - WS_PROJ + WS_SP) + (size_t)ldc * 3072 + col0;
#pragma unroll
            for (int ai = 0; ai < 2; ++ai)
#pragma unroll
                for (int m = 0; m < 4; ++m) {
                    const u32x4 uw = *(const u32x4*)(ucp + (size_t)(ai * HALF + m * 16) * 256);
                    const unsigned uws[4] = {uw.x, uw.y, uw.z, uw.w};
                    f32x4 la[2], bb[2];
#pragma unroll
                    for (int n = 0; n < 2; ++n) { const f32x4 ba = *(const f32x4*)(F + 4 * n), bi = *(const f32x4*)(F + 1024 + 4 * n), sp = *(const f32x4*)(F + 2048 + 4 * n);
#pragma unroll
                        for (int e = 0; e < 4; ++e) { const int j = 4 * n + e; const float uv = (j & 1) ? __uint_as_float(uws[j >> 1] & 0xffff0000u) : __uint_as_float(uws[j >> 1] << 16);
                            const float r = __builtin_amdgcn_rcpf(1.0f + __expf(-(acc[ai][0][m][n][e] + ba[e])));
                            const float ig = __builtin_amdgcn_rcpf(1.0f + __expf(-(acc[ai][1][m][n][e] + bi[e])));
                            const float l = r * sp[e]; la[n][e] = l; bb[n][e] = sqrtf(-expm1f(2.0f * l)) * (ig * uv); } }
                    *(u32x4*)(lap + (size_t)(ai * HALF + m * 16) * 2048) = pack8(la[0], la[1]);
                    *(u32x4*)(bbp + (size_t)(ai * HALF + m * 16) * 1024) = pack8(bb[0], bb[1]);
                    asm volatile("" ::: "memory"); }
        }
    }
};
struct GenOrder {
    int mode, nM, nN, nwg, G, c;
    __device__ __forceinline__ bool next(int i, Unit& u) const {
        const int L = i * G + c; if (L >= nwg) return false;
        if (mode == 0) {
            int wgid = L; { const int q = nwg / NXCD, r = nwg % NXCD, xcd = wgid % NXCD, off = wgid / NXCD; wgid = (xcd < r ? xcd * (q + 1) : r * (q + 1) + (xcd - r) * q) + off; }
            const int nig = WGM * nN, gid = wgid / nig, fm = gid * WGM, gsz = (nM - fm) < WGM ? (nM - fm) : WGM;
            u.pm = fm + ((wgid % nig) % gsz); u.pn = (wgid % nig) / gsz;
        } else if (mode == 1) {
            const int nb = L >> 7, r = L & 127; u.pm = nb * 64 + (r >> 1); u.pn = 2 * nb + (r & 1);
        } else {
            const int l = L >> 6, kind = (L >> 5) & 1, idx = L & 31;
            if (kind == 0) { u.pm = GenOrder_tA + l * 8 + (idx >> 2); u.pn = GenOrder_tB + l * 4 + (idx & 3); }
            else { u.pm = GenOrder_tC + l * 4 + (idx >> 3); u.pn = GenOrder_tA + l * 8 + (idx & 7); }
        }
        return true;
    }
    __device__ __forceinline__ void a_ready(const Unit&) const {}
    __device__ __forceinline__ void done(const Unit&) const {}
};
template <class Epi, class Sched, bool ALIGN_EPI = false, bool SP2 = false>
__device__ __forceinline__ void gemm_phase(PG8_LAS unsigned char* lds, const Gemm g, const Sched& S, const Epi& E) {
    int tid_ = threadIdx.x; asm volatile("" : "+v"(tid_));
    const int tid = tid_, wid = __builtin_amdgcn_readfirstlane(tid >> 6), lane = tid & 63, wr = wid >> 2, wc = wid & 3, fr = lane & 15, fq = lane >> 4;
    const int K = g.K, nt = K / BK;
    unsigned voffA[2], voffB[2];
#pragma unroll
    for (int i = 0; i < 2; ++i) { int R, C; stage_rc(tid * 16 + i * 8192, R, C); const int Rb = Epi::PERM ? ((R & ~31) + perm32(R & 31)) : R;
        voffA[i] = (unsigned)(R * K + C) * 2u; voffB[i] = (unsigned)(Rb * K + C) * 2u; }
    const size_t kstep = (size_t)(BK * 2);
    const size_t hstep = (size_t)HALF * K * 2;
    const size_t tstep = 2 * hstep;
    const unsigned ldsw = (unsigned)wid * 1024u;
    const int aoff = lds_byte(wr * 64 + fr, fq * 8), boff = lds_byte(wc * 32 + fr, fq * 8);
#define PG8_SA(b, h) (((b) * 2 + (h)) * HTB)
#define PG8_SB(b, h) ((4 + (b) * 2 + (h)) * HTB)
#define PG8_STAGE(bufoff, gbase, voff) do { _Pragma("unroll") for (int _i = 0; _i < 2; ++_i) \
        __builtin_amdgcn_global_load_lds((const unsigned*)((const char*)(gbase) + (voff)[_i]), (PG8_LAS unsigned*)(lds + (bufoff) + ldsw + _i * 8192), 16, 0, 0); } while (0)
#define PG8_LDA(dst, b, h) do { _Pragma("unroll") for (int m = 0; m < 4; ++m) _Pragma("unroll") for (int k = 0; k < 2; ++k) dst[m][k] = *(const PG8_LAS bf16x8*)(lds + PG8_SA(b, h) + aoff + m * 2048 + k * 1024); } while (0)
#define PG8_LDB(dst, b, h) do { _Pragma("unroll") for (int n = 0; n < 2; ++n) _Pragma("unroll") for (int k = 0; k < 2; ++k) dst[n][k] = *(const PG8_LAS bf16x8*)(lds + PG8_SB(b, h) + boff + n * 2048 + k * 1024); } while (0)
#define PG8_MMA(ai, bj, At, Bt) do { __builtin_amdgcn_s_setprio(1); _Pragma("unroll") for (int m = 0; m < 4; ++m) _Pragma("unroll") for (int n = 0; n < 2; ++n) _Pragma("unroll") for (int k = 0; k < 2; ++k) \
        acc[ai][bj][m][n] = __builtin_amdgcn_mfma_f32_16x16x32_bf16(Bt[n][k], At[m][k], acc[ai][bj][m][n], 0, 0, 0); __builtin_amdgcn_s_setprio(0); } while (0)
#define PG8_WAIT_V(n) asm volatile("s_waitcnt vmcnt(" #n ")" ::: "memory")
#define PG8_WAIT_L(n) asm volatile("s_waitcnt lgkmcnt(" #n ")" ::: "memory")
#define PG8_BAR __builtin_amdgcn_s_barrier()
#define PG8_SCHED __builtin_amdgcn_sched_barrier(0)
    Unit cur, nxt; int ui = 0;
    if (!S.next(0, cur)) return;
    f32x4 acc[2][2][4][2];
#pragma unroll
    for (int a = 0; a < 2; ++a)
#pragma unroll
        for (int b = 0; b < 2; ++b)
#pragma unroll
            for (int m = 0; m < 4; ++m)
#pragma unroll
                for (int n = 0; n < 2; ++n) acc[a][b][m][n] = (f32x4){0.f, 0.f, 0.f, 0.f};
    bf16x8 At[4][2], B0[2][2], B1[2][2];
    const char* cA = (const char*)g.A + (size_t)cur.pm * tstep; const char* cB = (const char*)g.Bt + (size_t)cur.pn * tstep;
    S.a_ready(cur);
    if constexpr (SP2) {
        PG8_STAGE(PG8_SB(0, 0), cB, voffB); PG8_STAGE(PG8_SB(0, 1), cB + hstep, voffB); PG8_STAGE(PG8_SA(0, 0), cA, voffA); PG8_STAGE(PG8_SA(0, 1), cA + hstep, voffA);
        if (wr == 1) PG8_BAR;
        PG8_WAIT_V(2); PG8_BAR;
        PG8_STAGE(PG8_SB(1, 0), cB + kstep, voffB); PG8_STAGE(PG8_SA(1, 0), cA + kstep, voffA); PG8_STAGE(PG8_SB(1, 1), cB + hstep + kstep, voffB);
        PG8_WAIT_V(6); PG8_BAR;
    } else {
        PG8_STAGE(PG8_SB(0, 0), cB, voffB); PG8_STAGE(PG8_SA(0, 0), cA, voffA); PG8_STAGE(PG8_SB(0, 1), cB + hstep, voffB); PG8_STAGE(PG8_SA(0, 1), cA + hstep, voffA);
        if (wr == 1) PG8_BAR;
        PG8_WAIT_V(4); PG8_BAR;
        PG8_STAGE(PG8_SB(1, 0), cB + kstep, voffB); PG8_STAGE(PG8_SA(1, 0), cA + kstep, voffA); PG8_STAGE(PG8_SB(1, 1), cB + hstep + kstep, voffB);
        PG8_WAIT_V(6); PG8_BAR;
    }
    for (;;) {
        const bool has_next = S.next(ui + 1, nxt);
        const char* nA = has_next ? (const char*)g.A + (size_t)nxt.pm * tstep : cA; const char* nB = has_next ? (const char*)g.Bt + (size_t)nxt.pn * tstep : cB;
        for (int t = 0; t < nt; t += 2) {
            const bool last = (t == nt - 2);
            const char* a1 = cA + (size_t)(t + 1) * kstep;
            const char* a2 = last ? nA : cA + (size_t)(t + 2) * kstep; const char* b2 = last ? nB : cB + (size_t)(t + 2) * kstep;
            const char* a3 = a2 + kstep; const char* b3 = b2 + kstep;
            if (last && has_next) S.a_ready(nxt);
            if constexpr (SP2) {
            PG8_LDB(B0, 0, 0); PG8_LDB(B1, 0, 1); PG8_SCHED; PG8_LDA(At, 0, 0); PG8_STAGE(PG8_SA(1, 1), a1 + hstep, voffA);
            PG8_WAIT_V(8); PG8_WAIT_L(0); PG8_BAR; PG8_MMA(0, 0, At, B0); PG8_MMA(0, 1, At, B1); PG8_BAR; PG8_SCHED;
            PG8_LDA(At, 0, 1); PG8_STAGE(PG8_SB(0, 0), b2, voffB); PG8_STAGE(PG8_SB(0, 1), b2 + hstep, voffB); PG8_STAGE(PG8_SA(0, 0), a2, voffA);
            PG8_WAIT_V(8); PG8_WAIT_L(0); PG8_BAR; PG8_MMA(1, 0, At, B0); PG8_MMA(1, 1, At, B1); PG8_BAR; PG8_SCHED;
            PG8_LDB(B0, 1, 0); PG8_LDB(B1, 1, 1); PG8_SCHED; PG8_LDA(At, 1, 0); PG8_STAGE(PG8_SA(0, 1), a2 + hstep, voffA);
            PG8_WAIT_V(8); PG8_WAIT_L(0); PG8_BAR; PG8_MMA(0, 0, At, B0); PG8_MMA(0, 1, At, B1); PG8_BAR; PG8_SCHED;
            PG8_LDA(At, 1, 1); PG8_STAGE(PG8_SB(1, 0), b3, voffB); PG8_STAGE(PG8_SB(1, 1), b3 + hstep, voffB); PG8_STAGE(PG8_SA(1, 0), a3, voffA);
            PG8_WAIT_V(8); PG8_WAIT_L(0); PG8_BAR; PG8_MMA(1, 0, At, B0); PG8_MMA(1, 1, At, B1); PG8_BAR; PG8_SCHED;
            } else {
            PG8_LDB(B0, 0, 0); PG8_SCHED; PG8_LDA(At, 0, 0); PG8_STAGE(PG8_SA(1, 1), a1 + hstep, voffA);
            PG8_WAIT_L(8); PG8_BAR; PG8_WAIT_L(0); PG8_MMA(0, 0, At, B0); PG8_BAR; PG8_SCHED;
            PG8_LDB(B1, 0, 1); PG8_STAGE(PG8_SB(0, 0), b2, voffB);
            PG8_BAR; PG8_WAIT_L(0); PG8_MMA(0, 1, At, B1); PG8_BAR;
            PG8_LDA(At, 0, 1); PG8_STAGE(PG8_SA(0, 0), a2, voffA);
            PG8_BAR; PG8_WAIT_L(0); PG8_MMA(1, 0, At, B0); PG8_BAR; PG8_SCHED;
            PG8_STAGE(PG8_SB(0, 1), b2 + hstep, voffB);
            PG8_WAIT_V(6); PG8_BAR; PG8_MMA(1, 1, At, B1); PG8_BAR;
            PG8_LDB(B0, 1, 0); PG8_SCHED; PG8_LDA(At, 1, 0); PG8_STAGE(PG8_SA(0, 1), a2 + hstep, voffA);
            PG8_WAIT_L(8); PG8_BAR; PG8_WAIT_L(0); PG8_MMA(0, 0, At, B0); PG8_BAR; PG8_SCHED;
            PG8_LDB(B1, 1, 1); PG8_STAGE(PG8_SB(1, 0), b3, voffB);
            PG8_BAR; PG8_WAIT_L(0); PG8_MMA(0, 1, At, B1); PG8_BAR;
            PG8_LDA(At, 1, 1); PG8_STAGE(PG8_SA(1, 0), a3, voffA);
            PG8_BAR; PG8_WAIT_L(0); PG8_MMA(1, 0, At, B0); PG8_BAR; PG8_SCHED;
            PG8_STAGE(PG8_SB(1, 1), b3 + hstep, voffB);
            PG8_WAIT_V(6); PG8_BAR; PG8_MMA(1, 1, At, B1); PG8_BAR;
            }
        }
        if constexpr (ALIGN_EPI) { if (wr == 0) PG8_BAR; }
        if constexpr (!Epi::AFTER_DRAIN) { E(acc, cur, wr, wc, fr, fq); S.done(cur); }
        if (!has_next) break;
#pragma unroll
        for (int a = 0; a < 2; ++a)
#pragma unroll
            for (int b = 0; b < 2; ++b)
#pragma unroll
                for (int m = 0; m < 4; ++m)
#pragma unroll
                    for (int n = 0; n < 2; ++n) acc[a][b][m][n] = (f32x4){0.f, 0.f, 0.f, 0.f};
        cur = nxt; cA = nA; cB = nB; ++ui;
        if constexpr (ALIGN_EPI) { if (wr == 1) PG8_BAR; }
    }
    PG8_WAIT_V(0);
    if constexpr (!ALIGN_EPI) { if (wr == 0) PG8_BAR; }
    PG8_BAR;
    if constexpr (Epi::AFTER_DRAIN) { E.fused(acc, cur, wr, wc, fr, fq, lds, wid, lane); S.done(cur); }
#undef PG8_SA
#undef PG8_SB
#undef PG8_STAGE
#undef PG8_LDA
#undef PG8_LDB
#undef PG8_MMA
#undef PG8_WAIT_V
#undef PG8_WAIT_L
#undef PG8_BAR
#undef PG8_SCHED
}
}

#define LAS __attribute__((address_space(3)))
typedef unsigned short bf16;
typedef float f32x4 __attribute__((ext_vector_type(4)));
typedef unsigned u32x4 __attribute__((ext_vector_type(4)));
typedef unsigned u32x2 __attribute__((ext_vector_type(2)));
typedef short bf16x8 __attribute__((ext_vector_type(8)));
#define MFMA16(a, b, c) __builtin_amdgcn_mfma_f32_16x16x32_bf16((a), (b), (c), 0, 0, 0)

__device__ __forceinline__ float bf_lo(unsigned w) { return __uint_as_float(w << 16); }
__device__ __forceinline__ float bf_hi(unsigned w) { return __uint_as_float(w & 0xffff0000u); }
__device__ __forceinline__ unsigned pk2(float lo, float hi) { return pg8::cvt_pk_bf16(lo, hi); }
__device__ __forceinline__ float wave_sum(float v) {
#pragma unroll
    for (int o = 1; o < 64; o <<= 1) v += __shfl_xor(v, o);
    return v;
}
__device__ __forceinline__ void unpack8(const u32x4 w, float (&v)[8]) { v[0] = bf_lo(w.x); v[1] = bf_hi(w.x); v[2] = bf_lo(w.y); v[3] = bf_hi(w.y); v[4] = bf_lo(w.z); v[5] = bf_hi(w.z); v[6] = bf_lo(w.w); v[7] = bf_hi(w.w); }
__device__ __forceinline__ u32x4 pack8f(const float (&v)[8]) { u32x4 w; w.x = pk2(v[0], v[1]); w.y = pk2(v[2], v[3]); w.z = pk2(v[4], v[5]); w.w = pk2(v[6], v[7]); return w; }

struct Args { const float* in[27]; float* out; unsigned char* ws; int ph_lo, ph_hi; };

__device__ __forceinline__ void xpose_item(const float* W, int ldw, int K, int col0, bf16* WT, int row0, int kb, LAS float* scr, int lane) {
    const int k0 = 64 * kb;
#pragma unroll 8
    for (int i = 0; i < 32; ++i) { const int kk = 2 * i + (lane >> 5); scr[kk * 33 + (lane & 31)] = W[(size_t)(k0 + kk) * ldw + col0 + (lane & 31)]; }
    asm volatile("s_waitcnt lgkmcnt(0)" ::: "memory");
    const int c = lane & 7;
#pragma unroll
    for (int j = 0; j < 4; ++j) { const int n = (lane >> 3) + 8 * j; const LAS float* s = scr + (8 * c) * 33 + n;
        u32x4 o; o.x = pk2(s[0 * 33], s[1 * 33]); o.y = pk2(s[2 * 33], s[3 * 33]); o.z = pk2(s[4 * 33], s[5 * 33]); o.w = pk2(s[6 * 33], s[7 * 33]);
        *(u32x4*)(WT + (size_t)(row0 + n) * K + k0 + 8 * c) = o; }
    asm volatile("s_waitcnt lgkmcnt(0)" ::: "memory");
}
__device__ __forceinline__ void prologue_item(const Args& a, unsigned char* ws, int it, LAS float* scr, int lane) {
    const int l = it / 8320; int r = it % 8320; const int hl = l >> 1;
    const float* W = nullptr; int ldw = DM, K = DM, col0 = 0, row0 = 0, kb = 0; bf16* WT = nullptr;
    if (r < 512) { W = a.in[9] + (size_t)l * DM * DM; col0 = 32 * (r & 31); WT = (bf16*)(ws + WS_WQ) + (size_t)l * DM * DM; row0 = col0; kb = r >> 5; }
    else if (r < 1024) { r -= 512; W = a.in[10] + (size_t)l * DM * 2 * DM; ldw = 2 * DM; col0 = 32 * (r & 31); WT = (bf16*)(ws + WS_WK) + (size_t)l * DM * DM; row0 = col0; kb = r >> 5; }
    else if (r < 1536) { r -= 1024; W = a.in[10] + (size_t)l * DM * 2 * DM; ldw = 2 * DM; row0 = 32 * (r & 31); col0 = DM + row0; WT = (bf16*)(ws + WS_WVT) + (size_t)l * DM * DM; kb = r >> 5; }
    else if (r < 2048) { r -= 1536; W = a.in[11] + (size_t)l * DM * DM; col0 = 32 * (r & 31); WT = (bf16*)(ws + WS_WO) + (size_t)l * DM * DM; row0 = col0; kb = r >> 5; }
    else if (r < 4864) { r -= 2048;
        const int rb = r % 176; kb = r / 176; row0 = 32 * rb; col0 = ((row0 >> 7) & 1) * DFF + (row0 >> 8) * 128 + (row0 & 127);
        W = a.in[12] + (size_t)l * DM * 2 * DFF; ldw = 2 * DFF; WT = (bf16*)(ws + WS_WGU) + (size_t)l * 2 * DFF * DM; }
    else if (r < 6272) { r -= 4864; W = a.in[13] + (size_t)l * DFF * DM; K = DFF; col0 = 32 * (r & 31); WT = (bf16*)(ws + WS_WDN) + (size_t)l * DM * DFF; row0 = col0; kb = r >> 5; }
    else if ((l & 1) == 0) { r -= 6272;
        if (r < 1280) { const int rb = r % 80; kb = r / 80; row0 = 32 * rb;
            col0 = row0 < 1024 ? row0 : row0 + 520; W = a.in[14] + (size_t)hl * DM * 3080; ldw = 3080; WT = (bf16*)(ws + WS_WIN) + (size_t)hl * 2560 * DM; }
        else if (r < 1536) { r -= 1280; W = a.in[14] + (size_t)hl * DM * 3080; ldw = 3080; row0 = 32 * (r & 15); col0 = 1024 + row0; WT = (bf16*)(ws + WS_WV) + (size_t)hl * 512 * DM; kb = r >> 4; }
        else { r -= 1536; W = a.in[17] + (size_t)hl * DM * DM; col0 = 32 * (r & 31); WT = (bf16*)(ws + WS_WOUT) + (size_t)hl * DM * DM; row0 = col0; kb = r >> 5; }
    } else { r -= 6272;
        if (r < 1024) { W = a.in[18] + (size_t)hl * DM * 2 * DM; ldw = 2 * DM; col0 = 32 * (r & 63); WT = (bf16*)(ws + WS_CIN) + (size_t)hl * 2 * DM * DM; row0 = col0; kb = r >> 6; }
        else if (r < 1280) { r -= 1024;
            const int rb = r & 63; kb = r >> 6; row0 = 32 * rb; const int nb = row0 >> 9, w = row0 & 511, jj = w >> 8, bj = (w >> 7) & 1, j = w & 127;
            W = (bj ? a.in[23] : a.in[21]) + (size_t)hl * 4 * 65536 + (size_t)nb * 65536; ldw = 256; K = 256; col0 = jj * 128 + j; WT = (bf16*)(ws + WS_CG) + (size_t)hl * 2048 * 256; }
        else if (r < 1792) { r -= 1280; W = a.in[26] + (size_t)hl * DM * DM; col0 = 32 * (r & 31); WT = (bf16*)(ws + WS_COUT) + (size_t)hl * DM * DM; row0 = col0; kb = r >> 5; }
    }
    if (W) xpose_item(W, ldw, K, col0, WT, row0, kb, scr, lane);
}

__device__ __forceinline__ void row_phase(const float* xsrc, const bf16* yb, const float* g_post, float* xdst, const float* g_pre, bf16* hdst,
                                          const float* wf, const float* bfg, float* logf, int gw, int NGW, int lane) {
    for (int row = gw; row < MT; row += NGW) {
        const f32x4* xr = (const f32x4*)(xsrc + (size_t)row * DM) + lane;
        f32x4 v[4];
#pragma unroll
        for (int j = 0; j < 4; ++j) v[j] = xr[64 * j];
        if (yb) {
            const u32x2* yr = (const u32x2*)(yb + (size_t)row * DM) + lane; f32x4 y[4]; float s = 0.f;
#pragma unroll
            for (int j = 0; j < 4; ++j) { const u32x2 w = yr[64 * j]; y[j] = (f32x4){bf_lo(w.x), bf_hi(w.x), bf_lo(w.y), bf_hi(w.y)}; s += (y[j].x * y[j].x + y[j].y * y[j].y) + (y[j].z * y[j].z + y[j].w * y[j].w); }
            const float rstd = 1.0f / sqrtf(wave_sum(s) * (1.0f / DM) + EPS);
#pragma unroll
            for (int j = 0; j < 4; ++j) { const f32x4 g = ((const f32x4*)g_post)[lane + 64 * j]; v[j] = v[j] + (y[j] * rstd) * g; }
            f32x4* xo = (f32x4*)(xdst + (size_t)row * DM) + lane;
#pragma unroll
            for (int j = 0; j < 4; ++j) xo[64 * j] = v[j];
        }
        if (g_pre) {
            float s = 0.f;
#pragma unroll
            for (int j = 0; j < 4; ++j) s += (v[j].x * v[j].x + v[j].y * v[j].y) + (v[j].z * v[j].z + v[j].w * v[j].w);
            const float rstd = 1.0f / sqrtf(wave_sum(s) * (1.0f / DM) + EPS);
            u32x2* ho = (u32x2*)(hdst + (size_t)row * DM) + lane;
#pragma unroll
            for (int j = 0; j < 4; ++j) { const f32x4 g = ((const f32x4*)g_pre)[lane + 64 * j]; v[j] = (v[j] * rstd) * g; u32x2 w; w.x = pk2(v[j].x, v[j].y); w.y = pk2(v[j].z, v[j].w); if (hdst) ho[64 * j] = w; }
            if (wf) {
                float mine = 0.f;
#pragma unroll
                for (int i = 0; i < 8; ++i) { float d = 0.f;
#pragma unroll
                    for (int j = 0; j < 4; ++j) { const f32x4 w = ((const f32x4*)wf)[i * 256 + lane + 64 * j]; d += (v[j].x * w.x + v[j].y * w.y) + (v[j].z * w.z + v[j].w * w.w); }
                    d = wave_sum(d); if (lane == i) mine = d; }
                if (lane < 8) { const float z = mine + bfg[lane]; logf[(size_t)row * 8 + lane] = fminf(z, 0.f) - log1pf(__expf(-fabsf(z))); }
            }
        }
    }
}

__device__ __forceinline__ void fox_unit(LAS unsigned char* lds, const bf16* PROJ, const bf16* VT, const float* LOGF, bf16* Y, int b, int h, int qb, int tid, int wid, int lane) {
    LAS float* cumL = (LAS float*)lds;
    LAS float* wtot = (LAS float*)(lds + 8192);
    LAS unsigned char* Kl = lds + 8192 + 256;
    LAS unsigned char* Vl = Kl + 9216;
    const int fr = lane & 15, fq = lane >> 4;
    const int hi = (qb + 1) * 256;
    const size_t tok0 = (size_t)b * SEQ;
    __syncthreads();
    {
        float e[4]; float run = 0.f;
#pragma unroll
        for (int i = 0; i < 4; ++i) { const int idx = 4 * tid + i; const float v = (idx < hi) ? LOGF[(tok0 + idx) * 8 + h] : 0.f; run += v; e[i] = run; }
        float sc = run;
#pragma unroll
        for (int o = 1; o < 64; o <<= 1) { const float t = __shfl_up(sc, o); if (lane >= o) sc += t; }
        if (lane == 63) wtot[wid] = sc;
        __syncthreads();
        float off = sc - run;
        for (int w = 0; w < wid; ++w) off += wtot[w];
#pragma unroll
        for (int i = 0; i < 4; ++i) cumL[4 * tid + i] = -(off + e[i]) * LOG2E;
    }
    const int q0w = qb * 256 + wid * 32;
    bf16x8 qf[2][2];
#pragma unroll
    for (int g = 0; g < 2; ++g)
#pragma unroll
        for (int kk = 0; kk < 2; ++kk) qf[g][kk] = *(const bf16x8*)(PROJ + (tok0 + q0w + 16 * g + fr) * 2560 + h * 64 + kk * 32 + fq * 8);
    const int srow = tid >> 3, sch = tid & 7;
    const bf16* kg = PROJ + (tok0 + srow) * 2560 + 512 + h * 64 + sch * 8;
    const bf16* vg = VT + (size_t)(h * 64 + srow) * MT + tok0 + sch * 8;
    const int jj = sch & 3, slot0 = 32 * (sch >> 2) + 16 * (jj & 1) + 4 * (jj >> 1);
    u32x4 kreg = *(const u32x4*)kg, vreg = *(const u32x4*)vg;
    const int nkt = (qb + 1) * 4;
    float mrun[2] = {-1e30f, -1e30f}, lrun[2] = {0.f, 0.f};
    f32x4 o[2][4];
#pragma unroll
    for (int g = 0; g < 2; ++g)
#pragma unroll
        for (int n = 0; n < 4; ++n) o[g][n] = (f32x4){0.f, 0.f, 0.f, 0.f};
    const float C2 = 0.125f * LOG2E;
    for (int kt = 0; kt < nkt; ++kt) {
        __syncthreads();
        *(LAS u32x4*)(Kl + srow * 144 + sch * 16) = kreg;
        *(LAS u32x2*)(Vl + srow * 144 + slot0 * 2) = (u32x2){vreg.x, vreg.y};
        *(LAS u32x2*)(Vl + srow * 144 + (slot0 + 8) * 2) = (u32x2){vreg.z, vreg.w};
        __syncthreads();
        if (kt + 1 < nkt) { kreg = *(const u32x4*)(kg + (size_t)(kt + 1) * 64 * 2560); vreg = *(const u32x4*)(vg + (kt + 1) * 64); }
        const int key0 = kt * 64;
        if (key0 <= q0w + 31) {
            f32x4 s[2][4];
#pragma unroll
            for (int n = 0; n < 4; ++n) {
                const bf16x8 k0 = *(const LAS bf16x8*)(Kl + (16 * n + fr) * 144 + fq * 16), k1 = *(const LAS bf16x8*)(Kl + (16 * n + fr) * 144 + 64 + fq * 16);
#pragma unroll
                for (int g = 0; g < 2; ++g) { s[g][n] = MFMA16(k0, qf[g][0], ((f32x4){0.f, 0.f, 0.f, 0.f})); s[g][n] = MFMA16(k1, qf[g][1], s[g][n]); }
            }
            const bool diag = key0 + 63 > q0w;
#pragma unroll
            for (int n = 0; n < 4; ++n) { const f32x4 cb = *(const LAS f32x4*)(cumL + key0 + 16 * n + 4 * fq);
#pragma unroll
                for (int g = 0; g < 2; ++g)
#pragma unroll
                    for (int e = 0; e < 4; ++e) { float v = s[g][n][e] * C2 + cb[e]; if (diag && (key0 + 16 * n + 4 * fq + e > q0w + 16 * g + fr)) v = -1e30f; s[g][n][e] = v; } }
            bf16x8 pf[2][2];
#pragma unroll
            for (int g = 0; g < 2; ++g) {
                float mx = -1e30f;
#pragma unroll
                for (int n = 0; n < 4; ++n) mx = fmaxf(mx, fmaxf(fmaxf(s[g][n][0], s[g][n][1]), fmaxf(s[g][n][2], s[g][n][3])));
                mx = fmaxf(mx, __shfl_xor(mx, 16)); mx = fmaxf(mx, __shfl_xor(mx, 32));
                const float mnew = fmaxf(mrun[g], mx), alpha = __builtin_amdgcn_exp2f(mrun[g] - mnew); mrun[g] = mnew;
                float rs = 0.f;
#pragma unroll
                for (int n = 0; n < 4; ++n)
#pragma unroll
                    for (int e = 0; e < 4; ++e) { const float p = __builtin_amdgcn_exp2f(s[g][n][e] - mnew); s[g][n][e] = p; rs += p; }
                lrun[g] = lrun[g] * alpha + rs;
#pragma unroll
                for (int n = 0; n < 4; ++n) o[g][n] = o[g][n] * alpha;
#pragma unroll
                for (int c = 0; c < 2; ++c) { const u32x4 w = pg8::pack8(s[g][2 * c], s[g][2 * c + 1]); pf[g][c] = __builtin_bit_cast(bf16x8, w); }
            }
#pragma unroll
            for (int n = 0; n < 4; ++n)
#pragma unroll
                for (int c = 0; c < 2; ++c) { const bf16x8 vf = *(const LAS bf16x8*)(Vl + (16 * n + fr) * 144 + c * 64 + fq * 16);
#pragma unroll
                    for (int g = 0; g < 2; ++g) o[g][n] = MFMA16(vf, pf[g][c], o[g][n]); }
        }
    }
#pragma unroll
    for (int g = 0; g < 2; ++g) {
        float l = lrun[g]; l += __shfl_xor(l, 16); l += __shfl_xor(l, 32);
        const float inv = 1.0f / l;
        bf16* yr = Y + (tok0 + q0w + 16 * g + fr) * DM + h * 64 + 4 * fq;
#pragma unroll
        for (int n = 0; n < 4; ++n) { u32x2 w; w.x = pk2(o[g][n][0] * inv, o[g][n][1] * inv); w.y = pk2(o[g][n][2] * inv, o[g][n][3] * inv); *(u32x2*)(yr + 16 * n) = w; }
    }
}

__device__ __forceinline__ void shortconv_items(const bf16* PROJ, const float* cw, bf16* Y, int gtid, int gthreads) {
    for (int it = gtid; it < (MT / 8) * 64; it += gthreads) {
        const int rb = it >> 6, c0 = (it & 63) * 8, t0 = rb * 8;
        float w0[8], w1[8], w2[8], p2[8], p1[8];
#pragma unroll
        for (int j = 0; j < 8; ++j) { w0[j] = cw[c0 + j]; w1[j] = cw[512 + c0 + j]; w2[j] = cw[1024 + c0 + j]; p2[j] = 0.f; p1[j] = 0.f; }
        if ((t0 & (SEQ - 1)) != 0) {
            float cv[8], uv[8];
            unpack8(*(const u32x4*)(PROJ + (size_t)(t0 - 2) * 2560 + 1536 + c0), cv); unpack8(*(const u32x4*)(PROJ + (size_t)(t0 - 2) * 2560 + 2048 + c0), uv);
#pragma unroll
            for (int j = 0; j < 8; ++j) p2[j] = cv[j] * uv[j];
            unpack8(*(const u32x4*)(PROJ + (size_t)(t0 - 1) * 2560 + 1536 + c0), cv); unpack8(*(const u32x4*)(PROJ + (size_t)(t0 - 1) * 2560 + 2048 + c0), uv);
#pragma unroll
            for (int j = 0; j < 8; ++j) p1[j] = cv[j] * uv[j];
        }
#pragma unroll
        for (int r = 0; r < 8; ++r) { const bf16* rowp = PROJ + (size_t)(t0 + r) * 2560;
            float bv[8], cv[8], uv[8], yv[8];
            unpack8(*(const u32x4*)(rowp + 1024 + c0), bv); unpack8(*(const u32x4*)(rowp + 1536 + c0), cv); unpack8(*(const u32x4*)(rowp + 2048 + c0), uv);
#pragma unroll
            for (int j = 0; j < 8; ++j) { const float cu = cv[j] * uv[j]; yv[j] = bv[j] * (w0[j] * p2[j] + w1[j] * p1[j] + w2[j] * cu); p2[j] = p1[j]; p1[j] = cu; }
            *(u32x4*)(Y + (size_t)(t0 + r) * DM + 512 + c0) = pack8f(yv); }
    }
}
__device__ __forceinline__ void lruconv_items(const bf16* U, const float* cw, const float* cb, bf16* UC, int gtid, int gthreads) {
    for (int it = gtid; it < (MT / 8) * 128; it += gthreads) {
        const int rb = it >> 7, c0 = (it & 127) * 8, t0 = rb * 8;
        float w0[8], w1[8], w2[8], w3[8], bb[8], p3[8], p2[8], p1[8];
#pragma unroll
        for (int j = 0; j < 8; ++j) { w0[j] = cw[c0 + j]; w1[j] = cw[1024 + c0 + j]; w2[j] = cw[2048 + c0 + j]; w3[j] = cw[3072 + c0 + j]; bb[j] = cb[c0 + j]; p3[j] = 0.f; p2[j] = 0.f; p1[j] = 0.f; }
        if ((t0 & (SEQ - 1)) != 0) { unpack8(*(const u32x4*)(U + (size_t)(t0 - 3) * 2 * DM + c0), p3); unpack8(*(const u32x4*)(U + (size_t)(t0 - 2) * 2 * DM + c0), p2); unpack8(*(const u32x4*)(U + (size_t)(t0 - 1) * 2 * DM + c0), p1); }
        bf16* dst = UC + ((size_t)(c0 >> 8) * MT + t0) * 256 + (c0 & 255);
#pragma unroll
        for (int r = 0; r < 8; ++r) { float uv[8], yv[8]; unpack8(*(const u32x4*)(U + (size_t)(t0 + r) * 2 * DM + c0), uv);
#pragma unroll
            for (int j = 0; j < 8; ++j) { yv[j] = w0[j] * p3[j] + w1[j] * p2[j] + w2[j] * p1[j] + w3[j] * uv[j] + bb[j]; p3[j] = p2[j]; p2[j] = p1[j]; p1[j] = uv[j]; }
            *(u32x4*)(dst + (size_t)r * 256) = pack8f(yv); }
    }
}
__device__ __forceinline__ void scan_item(LAS unsigned char* lds, const bf16* LA, const bf16* BB, const bf16* GT, bf16* Y, int item, int tid) {
    LAS float* sA = (LAS float*)lds; LAS float* sH = sA + 2048; LAS float* sC = sH + 2048;
    const int b = item >> 5, c0 = (item & 31) * 32 + (tid & 7) * 4, tc = tid >> 3;
    const size_t row0 = (size_t)b * SEQ + tc * 32;
    float A[4] = {1.f, 1.f, 1.f, 1.f}, Hh[4] = {0.f, 0.f, 0.f, 0.f};
#pragma unroll 8
    for (int r = 0; r < 32; ++r) { const u32x2 lw = *(const u32x2*)(LA + (row0 + r) * 2 * DM + c0), bw = *(const u32x2*)(BB + (row0 + r) * DM + c0);
        const float la[4] = {bf_lo(lw.x), bf_hi(lw.x), bf_lo(lw.y), bf_hi(lw.y)}, bv[4] = {bf_lo(bw.x), bf_hi(bw.x), bf_lo(bw.y), bf_hi(bw.y)};
#pragma unroll
        for (int j = 0; j < 4; ++j) { const float a = __expf(la[j]); Hh[j] = a * Hh[j] + bv[j]; A[j] *= a; } }
    __syncthreads();
#pragma unroll
    for (int j = 0; j < 4; ++j) { sA[tc * 32 + (tid & 7) * 4 + j] = A[j]; sH[tc * 32 + (tid & 7) * 4 + j] = Hh[j]; }
    __syncthreads();
    if (tid < 32) { float carry = 0.f; for (int t = 0; t < 64; ++t) { sC[t * 32 + tid] = carry; carry = sA[t * 32 + tid] * carry + sH[t * 32 + tid]; } }
    __syncthreads();
    float hc[4];
#pragma unroll
    for (int j = 0; j < 4; ++j) hc[j] = sC[tc * 32 + (tid & 7) * 4 + j];
#pragma unroll 8
    for (int r = 0; r < 32; ++r) { const u32x2 lw = *(const u32x2*)(LA + (row0 + r) * 2 * DM + c0), bw = *(const u32x2*)(BB + (row0 + r) * DM + c0), gw2 = *(const u32x2*)(GT + (row0 + r) * 2 * DM + c0);
        const float la[4] = {bf_lo(lw.x), bf_hi(lw.x), bf_lo(lw.y), bf_hi(lw.y)}, bv[4] = {bf_lo(bw.x), bf_hi(bw.x), bf_lo(bw.y), bf_hi(bw.y)}, gv[4] = {bf_lo(gw2.x), bf_hi(gw2.x), bf_lo(gw2.y), bf_hi(gw2.y)};
        float yv[4];
#pragma unroll
        for (int j = 0; j < 4; ++j) { hc[j] = __expf(la[j]) * hc[j] + bv[j]; const float x = gv[j], u = 0.7978845608f * (x + 0.044715f * x * x * x);
            yv[j] = x * __builtin_amdgcn_rcpf(1.0f + __expf(-2.0f * u)) * hc[j]; }
        u32x2 w; w.x = pk2(yv[0], yv[1]); w.y = pk2(yv[2], yv[3]); *(u32x2*)(Y + (row0 + r) * DM + c0) = w; }
}

__device__ __forceinline__ void cross_unit(LAS unsigned char* lds, const bf16* Q, const bf16* MK, const bf16* MVT, bf16* Y, int b, int h, int rb, int tid, int wid, int lane) {
    const int fr = lane & 15, fq = lane >> 4;
    const size_t tokw = (size_t)b * SEQ + rb * 256 + wid * 32;
    u32x4 pre[4];
#define CROSS_LOAD(st) do { int tl_ = tid; asm volatile("" : "+v"(tl_)); if ((st) < 4) { _Pragma("unroll") for (int i = 0; i < 4; ++i) { const int idx = tl_ + 512 * i, row = idx >> 3, ch = idx & 7; \
            pre[i] = *(const u32x4*)(MK + (size_t)(b * MEML + row) * DM + h * 256 + (st) * 64 + ch * 8); } } \
        else { _Pragma("unroll") for (int i = 0; i < 4; ++i) { const int idx = tl_ + 512 * i, d = idx >> 5, j = idx & 31; \
            pre[i] = *(const u32x4*)(MVT + (size_t)(h * 256 + ((st) - 4) * 64 + d) * 2048 + b * MEML + j * 8); } } } while (0)
#define CROSS_STORE(st) do { int tl_ = tid; asm volatile("" : "+v"(tl_)); if ((st) < 4) { _Pragma("unroll") for (int i = 0; i < 4; ++i) { const int idx = tl_ + 512 * i, row = idx >> 3, ch = idx & 7; *(LAS u32x4*)(lds + row * 144 + ch * 16) = pre[i]; } } \
        else { _Pragma("unroll") for (int i = 0; i < 4; ++i) { const int idx = tl_ + 512 * i, d = idx >> 5, j = idx & 31, jj = j & 3, slot0 = 32 * (j >> 2) + 16 * (jj & 1) + 4 * (jj >> 1); \
            *(LAS u32x2*)(lds + d * 528 + slot0 * 2) = (u32x2){pre[i].x, pre[i].y}; *(LAS u32x2*)(lds + d * 528 + (slot0 + 8) * 2) = (u32x2){pre[i].z, pre[i].w}; } } } while (0)
    CROSS_LOAD(0);
    f32x4 s[2][16];
#pragma unroll
    for (int g = 0; g < 2; ++g)
#pragma unroll
        for (int n = 0; n < 16; ++n) s[g][n] = (f32x4){0.f, 0.f, 0.f, 0.f};
    for (int dc = 0; dc < 4; ++dc) {
        __syncthreads(); CROSS_STORE(0); __syncthreads();
        CROSS_LOAD(dc + 1);
        bf16x8 qf[2][2];
#pragma unroll
        for (int g = 0; g < 2; ++g)
#pragma unroll
            for (int kk = 0; kk < 2; ++kk) qf[g][kk] = *(const bf16x8*)(Q + (tokw + 16 * g + fr) * DM + h * 256 + dc * 64 + kk * 32 + fq * 8);
#pragma unroll
        for (int n = 0; n < 16; ++n) {
            const bf16x8 k0 = *(const LAS bf16x8*)(lds + (16 * n + fr) * 144 + fq * 16), k1 = *(const LAS bf16x8*)(lds + (16 * n + fr) * 144 + 64 + fq * 16);
#pragma unroll
            for (int g = 0; g < 2; ++g) { s[g][n] = MFMA16(k0, qf[g][0], s[g][n]); s[g][n] = MFMA16(k1, qf[g][1], s[g][n]); }
        }
    }
    bf16x8 pf[2][8]; float inv[2];
    const float SC = 0.0625f * LOG2E;
#pragma unroll
    for (int g = 0; g < 2; ++g) {
        float mx = -1e30f;
#pragma unroll
        for (int n = 0; n < 16; ++n) mx = fmaxf(mx, fmaxf(fmaxf(s[g][n][0], s[g][n][1]), fmaxf(s[g][n][2], s[g][n][3])));
        mx = fmaxf(mx, __shfl_xor(mx, 16)); mx = fmaxf(mx, __shfl_xor(mx, 32));
        const float mb = mx * SC;
        float rs = 0.f;
#pragma unroll
        for (int c = 0; c < 8; ++c) { f32x4 p0, p1;
#pragma unroll
            for (int e = 0; e < 4; ++e) { p0[e] = __builtin_amdgcn_exp2f(s[g][2 * c][e] * SC - mb); p1[e] = __builtin_amdgcn_exp2f(s[g][2 * c + 1][e] * SC - mb); }
            rs += (p0[0] + p0[1]) + (p0[2] + p0[3]) + (p1[0] + p1[1]) + (p1[2] + p1[3]);
            const u32x4 w = pg8::pack8(p0, p1); pf[g][c] = __builtin_bit_cast(bf16x8, w); }
        rs += __shfl_xor(rs, 16); rs += __shfl_xor(rs, 32); inv[g] = 1.0f / rs;
        asm volatile("" ::: "memory");
    }
    for (int dc = 0; dc < 4; ++dc) {
        __syncthreads(); CROSS_STORE(4); __syncthreads();
        if (dc + 1 < 4) CROSS_LOAD(dc + 5);
        f32x4 o[2][4];
#pragma unroll
        for (int g = 0; g < 2; ++g)
#pragma unroll
            for (int n = 0; n < 4; ++n) o[g][n] = (f32x4){0.f, 0.f, 0.f, 0.f};
#pragma unroll
        for (int n = 0; n < 4; ++n)
#pragma unroll
            for (int c = 0; c < 8; ++c) { const bf16x8 vf = *(const LAS bf16x8*)(lds + (16 * n + fr) * 528 + c * 64 + fq * 16);
#pragma unroll
                for (int g = 0; g < 2; ++g) o[g][n] = MFMA16(vf, pf[g][c], o[g][n]); }
#pragma unroll
        for (int g = 0; g < 2; ++g) { bf16* yr = Y + (tokw + 16 * g + fr) * DM + h * 256 + dc * 64 + 4 * fq;
#pragma unroll
            for (int n = 0; n < 4; ++n) { u32x2 w; w.x = pk2(o[g][n][0] * inv[g], o[g][n][1] * inv[g]); w.y = pk2(o[g][n][2] * inv[g], o[g][n][3] * inv[g]); *(u32x2*)(yr + 16 * n) = w; } }
    }
#undef CROSS_LOAD
#undef CROSS_STORE
}

struct GD { const bf16* A; const bf16* Bt; int nM, nN, nwg, K, omode, emode, coff; bf16* O; int ldc; };
__device__ __forceinline__ GD gd_plain(const bf16* A, const bf16* Bt, int M, int N, int K, bf16* O, int ldc) {
    GD d{}; d.A = A; d.Bt = Bt; d.nM = M / 256; d.nN = N / 256; d.nwg = d.nM * d.nN; d.K = K; d.O = O; d.ldc = ldc; return d; }
enum { OP_NONE = 0, OP_PRO, OP_FOX, OP_ROW, OP_CROSS, OP_LRUCONV, OP_SCAN };

__global__ void __launch_bounds__(512, 2) hybrid_fwd(Args a) {
    extern __shared__ __attribute__((aligned(16))) unsigned char lds_raw[];
    LAS unsigned char* lds = (LAS unsigned char*)lds_raw;
    const int G = gridDim.x, bx = blockIdx.x, NGW = G * 8;

    for (int ph = a.ph_lo; ph < a.ph_hi; ++ph) {
        unsigned char* ws = a.ws; asm volatile("" : "+s"(ws));
        bf16* const H = (bf16*)(ws + WS_H); bf16* const PROJ = (bf16*)(ws + WS_PROJ); bf16* const Yb = (bf16*)(ws + WS_Y);
        float* const LOGF = (float*)(ws + WS_LOGF); float* const WF = (float*)(ws + WS_WF); float* const SPT = (float*)(ws + WS_SP);
        float* const X = a.out;
        int n0 = 0, op = OP_NONE;
        int l = 0, code = -1;
        if (ph == 0) op = OP_PRO;
        else { const int pp = (ph - 1) % 24, pair = (ph - 1) / 24; if (pp < 11) { l = 2 * pair; code = pp; } else { l = 2 * pair + 1; code = 16 + (pp - 11); } }
        const int hl = l >> 1;
        switch (code) {
        case 0: n0 = (l == 0) ? 3 : 2; if (l == 0) op = OP_ROW; break;
        case 1: op = OP_FOX; break;
        case 17: op = OP_LRUCONV; break;
        case 19: op = OP_SCAN; break;
        case 5: case 23: op = OP_CROSS; break;
        case 3: case 21: case 7: case 25: case 10: case 28: op = OP_ROW; break;
        default: n0 = 1; break;
        }
#ifndef NO_G0
        for (int gi = 0; gi < n0; ++gi) {
            GD g{};
            switch (code) {
            case 0:
                if (gi == 0) g = gd_plain(H, (const bf16*)(ws + WS_WIN) + (size_t)hl * 2560 * DM, MT, 2560, DM, PROJ, 2560);
                else if (gi == 1) { g = gd_plain((const bf16*)(ws + WS_WV) + (size_t)hl * 512 * DM, H, 512, MT, DM, PROJ + (size_t)MT * 2560, MT); g.coff = G / 2; }
                else { g.A = (const bf16*)ws; g.Bt = (const bf16*)ws; g.nwg = 256; g.K = DM; g.omode = 2; g.emode = 1; g.O = (bf16*)(ws + WS_MEMK); }
                break;
            case 2: g = gd_plain(Yb, (const bf16*)(ws + WS_WOUT) + (size_t)hl * DM * DM, MT, DM, DM, H, DM); break;
            case 16: g = gd_plain(H, (const bf16*)(ws + WS_CIN) + (size_t)hl * 2 * DM * DM, MT, 2 * DM, DM, PROJ, 2 * DM); break;
            case 18:
                g.A = PROJ + (size_t)2 * MT * DM; g.Bt = (const bf16*)(ws + WS_CG) + (size_t)hl * 2048 * 256; g.nwg = 512; g.K = 256; g.omode = 1; g.emode = 3;
                g.O = PROJ + DM; g.ldc = hl; break;
            case 20: g = gd_plain(Yb, (const bf16*)(ws + WS_COUT) + (size_t)hl * DM * DM, MT, DM, DM, H, DM); break;
            case 4: case 22: g = gd_plain(H, (const bf16*)(ws + WS_WQ) + (size_t)l * DM * DM, MT, DM, DM, PROJ, DM); break;
            case 6: case 24: g = gd_plain(Yb, (const bf16*)(ws + WS_WO) + (size_t)l * DM * DM, MT, DM, DM, H, DM); break;
            case 8: case 26: g = gd_plain(H, (const bf16*)(ws + WS_WGU) + (size_t)l * 2 * DFF * DM, MT, 2 * DFF, DM, PROJ, DFF); g.emode = 2; break;
            default: g = gd_plain(PROJ, (const bf16*)(ws + WS_WDN) + (size_t)l * DM * DFF, MT, DM, DFF, H, DM); break;
            }
            pg8::Gemm gg{g.A, g.Bt, 0, 0, g.K};
            pg8::GenOrder S{g.omode, g.nM, g.nN, g.nwg, G, (bx + g.coff) % G};
            pg8::EpiAll E{g.emode, g.O, g.ldc};
            pg8::gemm_phase<pg8::EpiAll, pg8::GenOrder, true, true>(lds, gg, S, E);
        }
#endif
        const float* r_g_post = nullptr; const float* r_g_pre = nullptr; const float* r_xsrc = X; const float* r_wf = nullptr; const float* r_bf = nullptr;
        const bf16* r_y = H; bf16* r_h = H;
        switch (code) {
        case 0: r_xsrc = a.in[0]; r_y = nullptr; r_g_pre = a.in[2]; r_h = nullptr; r_wf = WF; r_bf = a.in[15]; break;
        case 3: case 21: r_g_post = a.in[3] + l * DM; r_g_pre = a.in[4] + l * DM; if (l == 0) r_xsrc = a.in[0]; break;
        case 7: case 25: r_g_post = a.in[6] + l * DM; r_g_pre = a.in[7] + l * DM; break;
        case 10: case 28:
            r_g_post = a.in[8] + l * DM;
            if (l != 3) { r_g_pre = a.in[2] + (l + 1) * DM; if (l & 1) { r_wf = WF + (size_t)((l + 1) >> 1) * 8 * DM; r_bf = a.in[15] + ((l + 1) >> 1) * 8; } }
            break;
        default: break;
        }
        int tid = threadIdx.x; asm volatile("" : "+v"(tid));
        const int lane = tid & 63, wid = __builtin_amdgcn_readfirstlane(tid >> 6), gw = bx * 8 + wid;
        if (false) {}
#ifndef NO_PRO
        else if (op == OP_PRO) {
            LAS float* scr = (LAS float*)(lds + wid * 16384);
            for (int it = gw; it < 4 * 8320; it += NGW) prologue_item(a, ws, it, scr, lane);
            for (int idx = bx * 512 + tid; idx < 2 * 8 * DM; idx += G * 512) { const int e = idx >> 13, i = (idx >> 10) & 7, k = idx & 1023; WF[idx] = a.in[14][(size_t)e * DM * 3080 + (size_t)k * 3080 + 1536 + i]; }
            for (int idx = bx * 512 + tid; idx < 2 * DM; idx += G * 512) { const int o = idx >> 10, c = idx & 1023; const float z = -a.in[25][idx];
                SPT[o * 3 * DM + c] = a.in[22][idx]; SPT[o * 3 * DM + DM + c] = a.in[24][idx]; SPT[o * 3 * DM + 2 * DM + c] = -8.0f * (fmaxf(z, 0.f) + log1pf(__expf(-fabsf(z)))); }
            for (int row = gw; row < NB * MEML; row += NGW) {
                const f32x4* xr = (const f32x4*)(a.in[1] + (size_t)row * DM) + lane; f32x4 v[4]; float s = 0.f;
#pragma unroll
                for (int j = 0; j < 4; ++j) { v[j] = xr[64 * j]; s += (v[j].x * v[j].x + v[j].y * v[j].y) + (v[j].z * v[j].z + v[j].w * v[j].w); }
                const float rstd = 1.0f / sqrtf(wave_sum(s) * (1.0f / DM) + EPS);
                for (int ll = 0; ll < 4; ++ll) { u32x2* ho = (u32x2*)(Yb + ((size_t)ll * NB * MEML + row) * DM) + lane;
#pragma unroll
                    for (int j = 0; j < 4; ++j) { const f32x4 g = ((const f32x4*)(a.in[5] + ll * DM))[lane + 64 * j]; const f32x4 t = (v[j] * rstd) * g; u32x2 w; w.x = pk2(t.x, t.y); w.y = pk2(t.z, t.w); ho[64 * j] = w; } }
            }
            row_phase(a.in[0], nullptr, nullptr, nullptr, a.in[2], H, nullptr, nullptr, nullptr, gw, NGW, lane);
        }
#endif
#ifndef NO_FOX
        else if (op == OP_FOX) {
            const bf16* VT = PROJ + (size_t)MT * 2560;
            if (G == 256) { const int bh = bx >> 2, s4 = bx & 3;
                for (int i = 0; i < 2; ++i) fox_unit(lds, PROJ, VT, LOGF, Yb, bh >> 3, bh & 7, i ? 7 - s4 : s4, tid, wid, lane); }
            else { for (int u = bx; u < 512; u += G) fox_unit(lds, PROJ, VT, LOGF, Yb, u >> 6, (u >> 3) & 7, u & 7, tid, wid, lane); }
            shortconv_items(PROJ, a.in[16] + (size_t)hl * 3 * 512, Yb, bx * 512 + tid, G * 512);
        }
#endif
#ifndef NO_ROW
        else if (op == OP_ROW) {
            row_phase(r_xsrc, r_y, r_g_post, X, r_g_pre, r_h, r_wf, r_bf, LOGF, gw, NGW, lane);
        }
#endif
#ifndef NO_CROSS
        else if (op == OP_CROSS) {
            for (int u = bx; u < 256; u += G) { cross_unit(lds, PROJ, (const bf16*)(ws + WS_MEMK) + (size_t)l * 2048 * DM, (const bf16*)(ws + WS_MEMVT) + (size_t)l * 2048 * DM, Yb, u >> 5, (u >> 3) & 3, u & 7, tid, wid, lane); __syncthreads(); }
        }
#endif
#ifndef NO_LRUCONV
        else if (op == OP_LRUCONV) {
            lruconv_items(PROJ + DM, a.in[19] + (size_t)hl * 4 * DM, a.in[20] + (size_t)hl * DM, PROJ + (size_t)2 * MT * DM, bx * 512 + tid, G * 512);
        }
#endif
#ifndef NO_SCAN
        else if (op == OP_SCAN) {
            for (int it = bx; it < 256; it += G) scan_item(lds, PROJ + DM, H, PROJ, Yb, it, tid);
        }
#endif
        if (ph + 1 < a.ph_hi) cg::this_grid().sync();
    }
}

extern "C" void kernel_launch(void* const* d_in, const int* in_sizes, int n_in, void* d_out, int out_size, void* d_ws, size_t ws_size, hipStream_t stream) {
    static int grid = 0;
    if (grid == 0) {
        if (n_in != 27 || out_size != MT * DM || ws_size < WS_END) { fprintf(stderr, "kernel_launch: unexpected shapes (n_in %d, out %d, ws %zu)\n", n_in, out_size, ws_size); grid = -1; return; }
        int dev = 0, cus = 0, per_cu = 0;
        (void)hipGetDevice(&dev); (void)hipDeviceGetAttribute(&cus, hipDeviceAttributeMultiprocessorCount, dev);
        if (hipFuncSetAttribute((const void*)hybrid_fwd, hipFuncAttributeMaxDynamicSharedMemorySize, LDS_BYTES) != hipSuccess) { fprintf(stderr, "kernel_launch: hipFuncSetAttribute failed\n"); grid = -1; return; }
        if (hipOccupancyMaxActiveBlocksPerMultiprocessor(&per_cu, (const void*)hybrid_fwd, 512, LDS_BYTES) != hipSuccess || per_cu < 1) { fprintf(stderr, "kernel_launch: occupancy query says %d\n", per_cu); per_cu = 1; }
        (void)hipGetLastError();
        grid = cus;
    }
    if (grid < 0) return;
    Args a{};
    for (int i = 0; i < 27; ++i) a.in[i] = (const float*)d_in[i];
    a.out = (float*)d_out; a.ws = (unsigned char*)d_ws;
#if N_LAUNCH_PER_PHASE
    for (int ph = 0; ph < NPHASE; ++ph) { a.ph_lo = ph; a.ph_hi = ph + 1; hipLaunchKernelGGL(hybrid_fwd, dim3(grid), dim3(512), LDS_BYTES, stream, a); }
#else
    a.ph_lo = 0; a.ph_hi = NPHASE;
    void* args[] = {&a};
    hipError_t e = hipLaunchCooperativeKernel((const void*)hybrid_fwd, dim3(grid), dim3(512), args, LDS_BYTES, stream);
    if (e != hipSuccess) fprintf(stderr, "cooperative launch failed: %s (grid %d)\n", hipGetErrorString(e), grid);
#endif
}
```

```cpp
#include <hip/hip_runtime.h>
#include <hip/hip_cooperative_groups.h>
#include <cstdio>
#include <cstdint>
namespace cg = cooperative_groups;
#ifndef N_LAUNCH_PER_PHASE
#define N_LAUNCH_PER_PHASE 0
#endif
constexpr int DM = 1024, SEQ = 2048, NB = 8, MT = NB * SEQ  , DFF = 2816, MEML = 256;
constexpr float EPS = 1e-6f, LOG2E = 1.4426950408889634f;
constexpr size_t MiB = 1u << 20;
constexpr size_t WS_WQ = 0 * MiB, WS_WK = 8 * MiB, WS_WVT = 16 * MiB, WS_WO = 24 * MiB, WS_WGU = 32 * MiB, WS_WDN = 76 * MiB, WS_WIN = 98 * MiB, WS_WV = 108 * MiB,
                 WS_WOUT = 110 * MiB, WS_CIN = 114 * MiB, WS_CG = 122 * MiB, WS_COUT = 124 * MiB, WS_MEMK = 128 * MiB, WS_MEMVT = 144 * MiB, WS_H = 160 * MiB,
                 WS_PROJ = 192 * MiB, WS_Y = 288 * MiB, WS_LOGF = 320 * MiB, WS_WF = 320 * MiB + 512 * 1024, WS_SP = WS_WF + 65536, WS_BAR = 320 * MiB + 768 * 1024, WS_END = 321 * MiB;
constexpr int LDS_BYTES = 147456;
constexpr int NPHASE = 49;

namespace pg8 {
#define PG8_LAS __attribute__((address_space(3)))
typedef unsigned short bf16_t;
typedef short bf16x8 __attribute__((ext_vector_type(8)));
typedef float f32x4 __attribute__((ext_vector_type(4)));
typedef unsigned u32x4 __attribute__((ext_vector_type(4)));
constexpr int BM = 256, BK = 64, HALF = 128, HTB = HALF * BK * 2  , STAGE_BYTES = 8 * HTB, NXCD = 8, WGM = 8;

__host__ __device__ __forceinline__ int lds_byte(int r, int c) { const int st = (r >> 4) * 2 + (c >> 5), rr = r & 15, cc = c & 31, ob = rr * 64 + cc * 2; return st * 1024 + (ob ^ (((ob >> 9) & 1) << 5)); }
__host__ __device__ __forceinline__ void stage_rc(int b, int& R, int& C) { const int st = b / 1024, sb = b % 1024, swz = sb ^ (((sb >> 9) & 1) << 5); R = (st >> 1) * 16 + swz / 64; C = (st & 1) * 32 + (swz % 64) / 2; }
__host__ __device__ __forceinline__ int perm32(int rho) { const int n = rho >> 4, i = rho & 15; return 8 * (i >> 2) + 4 * n + (i & 3); }

struct Unit { int pm, pn; };
struct Gemm { const bf16_t* A; const bf16_t* Bt; int M, N, K; };

struct StaticOrder {
    int nM, nN, nwg, G, c;
    __host__ __device__ void init(int M, int N, int G_, int c_) { nM = M / BM; nN = N / BM; nwg = nM * nN; G = G_; c = c_; }
    __host__ __device__ bool next(int i, Unit& u) const {
        const long L = (long)i * G + c; if (L >= nwg) return false;
        int wgid = (int)L; { const int q = nwg / NXCD, r = nwg % NXCD, xcd = wgid % NXCD, off = wgid / NXCD; wgid = (xcd < r ? xcd * (q + 1) : r * (q + 1) + (xcd - r) * q) + off; }
        const int nig = WGM * nN, gid = wgid / nig, fm = gid * WGM, gsz = (nM - fm) < WGM ? (nM - fm) : WGM;
        u.pm = fm + ((wgid % nig) % gsz); u.pn = (wgid % nig) / gsz; return true;
    }
    __device__ __forceinline__ void a_ready(const Unit&) const {}
    __device__ __forceinline__ void done(const Unit&) const {}
};

__device__ __forceinline__ unsigned cvt_pk_bf16(float lo, float hi) { unsigned r; asm volatile("v_cvt_pk_bf16_f32 %0, %1, %2" : "=v"(r) : "v"(lo), "v"(hi)); return r; }
typedef float f32x2 __attribute__((ext_vector_type(2)));
__device__ __forceinline__ u32x4 pack8(const f32x4 v0, const f32x4 v1) { u32x4 w; w.x = cvt_pk_bf16(v0[0], v0[1]); w.y = cvt_pk_bf16(v0[2], v0[3]); w.z = cvt_pk_bf16(v1[0], v1[1]); w.w = cvt_pk_bf16(v1[2], v1[3]); return w; }
__device__ __forceinline__ void store_tile_bf16(const f32x4 (&acc)[2][2][4][2], bf16_t* tile, size_t ldc, int wr, int wc, int fr, int fq) {
#pragma unroll
    for (int ai = 0; ai < 2; ++ai)
#pragma unroll
        for (int m = 0; m < 4; ++m) { bf16_t* rowp = tile + (size_t)(ai * HALF + wr * 64 + m * 16 + fr) * ldc + wc * 32 + 8 * fq;
#pragma unroll
            for (int bj = 0; bj < 2; ++bj) *(u32x4*)(rowp + bj * HALF) = pack8(acc[ai][bj][m][0], acc[ai][bj][m][1]); }
}
constexpr int GenOrder_tA = (int)(WS_Y / (512 * 1024)), GenOrder_tB = (int)(WS_WK / (512 * 1024)), GenOrder_tC = (int)(WS_WVT / (512 * 1024));
struct EpiAll {
    static constexpr bool PERM = true, AFTER_DRAIN = false;
    int mode; bf16_t* O; int ldc;
    __device__ __forceinline__ void operator()(const f32x4 (&acc)[2][2][4][2], const Unit& u, int, int, int, int) const {
        int t_ = threadIdx.x; asm volatile("" : "+v"(t_));
        const int wid_ = t_ >> 6, wr = wid_ >> 2, wc = wid_ & 3, fr = t_ & 15, fq = (t_ & 63) >> 4;
        if (mode <= 1) {
            bf16_t* base = O; size_t ld = (size_t)ldc; int om = u.pm, on = u.pn;
            if (mode == 1) { if (u.pm >= GenOrder_tA) { const int t = u.pm - GenOrder_tA; base += (size_t)(t >> 3) * 2048 * 1024; ld = 1024; om = t & 7; on = (u.pn - GenOrder_tB) & 3; }
                             else { const int t = u.pm - GenOrder_tC; base += (size_t)8 * 1024 * 1024 + (size_t)(t >> 2) * 2048 * 1024; ld = 2048; om = t & 3; on = (u.pn - GenOrder_tA) & 7; } }
            store_tile_bf16(acc, base + (size_t)om * BM * ld + (size_t)on * BM, ld, wr, wc, fr, fq);
        } else if (mode == 2) {
            bf16_t* tile = O + (size_t)u.pm * BM * ldc + (size_t)u.pn * HALF;
#pragma unroll
            for (int ai = 0; ai < 2; ++ai)
#pragma unroll
                for (int m = 0; m < 4; ++m) { bf16_t* rowp = tile + (size_t)(ai * HALF + wr * 64 + m * 16 + fr) * ldc + wc * 32 + 8 * fq;
                    f32x4 o[2];
#pragma unroll
                    for (int n = 0; n < 2; ++n)
#pragma unroll
                        for (int e = 0; e < 4; ++e) { const float g = acc[ai][0][m][n][e], up = acc[ai][1][m][n][e]; o[n][e] = g * __builtin_amdgcn_rcpf(1.0f + __expf(-g)) * up; }
                    *(u32x4*)rowp = pack8(o[0], o[1]); }
        } else {
            const int om = u.pm & 63;
            const int col0 = u.pn * HALF + wc * 32 + 8 * fq;
            const bf16_t* ucp = O + (size_t)16384 * 2048 - 1024 + ((size_t)(col0 >> 8) * 16384 + (size_t)om * BM + wr * 64 + fr) * 256 + (col0 & 255);
            bf16_t* bbp = (bf16_t*)((unsigned char*)O - 2048 - (WS_PROJ - WS_H)) + ((size_t)om * BM + wr * 64 + fr) * 1024 + col0;
            bf16_t* lap = O + ((size_t)om * BM + wr * 64 + fr) * 2048 + col0;
            const float* F = (const float*)((unsigned char*)O - 2048 - WS_PROJ + WS_SP) + (size_t)ldc * 3072 + col0;
#pragma unroll
            for (int ai = 0; ai < 2; ++ai)
#pragma unroll
                for (int m = 0; m < 4; ++m) {
                    const u32x4 uw = *(const u32x4*)(ucp + (size_t)(ai * HALF + m * 16) * 256);
                    const unsigned uws[4] = {uw.x, uw.y, uw.z, uw.w};
                    f32x4 la[2], bb[2];
#pragma unroll
                    for (int n = 0; n < 2; ++n) { const f32x4 ba = *(const f32x4*)(F + 4 * n), bi = *(const f32x4*)(F + 1024 + 4 * n), sp = *(const f32x4*)(F + 2048 + 4 * n);
#pragma unroll
                        for (int e = 0; e < 4; ++e) { const int j = 4 * n + e; const float uv = (j & 1) ? __uint_as_float(uws[j >> 1] & 0xffff0000u) : __uint_as_float(uws[j >> 1] << 16);
                            const float r = __builtin_amdgcn_rcpf(1.0f + __expf(-(acc[ai][0][m][n][e] + ba[e])));
                            const float ig = __builtin_amdgcn_rcpf(1.0f + __expf(-(acc[ai][1][m][n][e] + bi[e])));
                            const float l = r * sp[e]; la[n][e] = l; bb[n][e] = sqrtf(-expm1f(2.0f * l)) * (ig * uv); } }
                    *(u32x4*)(lap + (size_t)(ai * HALF + m * 16) * 2048) = pack8(la[0], la[1]);
                    *(u32x4*)(bbp + (size_t)(ai * HALF + m * 16) * 1024) = pack8(bb[0], bb[1]);
                    asm volatile("" ::: "memory"); }
        }
    }
};
struct GenOrder {
    int mode, nM, nN, nwg, G, c;
    __device__ __forceinline__ bool next(int i, Unit& u) const {
        const int L = i * G + c; if (L >= nwg) return false;
        if (mode == 0) {
            int wgid = L; { const int q = nwg / NXCD, r = nwg % NXCD, xcd = wgid % NXCD, off = wgid / NXCD; wgid = (xcd < r ? xcd * (q + 1) : r * (q + 1) + (xcd - r) * q) + off; }
            const int nig = WGM * nN, gid = wgid / nig, fm = gid * WGM, gsz = (nM - fm) < WGM ? (nM - fm) : WGM;
            u.pm = fm + ((wgid % nig) % gsz); u.pn = (wgid % nig) / gsz;
        } else if (mode == 1) {
            const int nb = L >> 7, r = L & 127; u.pm = nb * 64 + (r >> 1); u.pn = 2 * nb + (r & 1);
        } else {
            const int l = L >> 6, kind = (L >> 5) & 1, idx = L & 31;
            if (kind == 0) { u.pm = GenOrder_tA + l * 8 + (idx >> 2); u.pn = GenOrder_tB + l * 4 + (idx & 3); }
            else { u.pm = GenOrder_tC + l * 4 + (idx >> 3); u.pn = GenOrder_tA + l * 8 + (idx & 7); }
        }
        return true;
    }
    __device__ __forceinline__ void a_ready(const Unit&) const {}
    __device__ __forceinline__ void done(const Unit&) const {}
};
template <class Epi, class Sched, bool ALIGN_EPI = false, bool SP2 = false>
__device__ __forceinline__ void gemm_phase(PG8_LAS unsigned char* lds, const Gemm g, const Sched& S, const Epi& E) {
    int tid_ = threadIdx.x; asm volatile("" : "+v"(tid_));
    const int tid = tid_, wid = __builtin_amdgcn_readfirstlane(tid >> 6), lane = tid & 63, wr = wid >> 2, wc = wid & 3, fr = lane & 15, fq = lane >> 4;
    const int K = g.K, nt = K / BK;
    unsigned voffA[2], voffB[2];
#pragma unroll
    for (int i = 0; i < 2; ++i) { int R, C; stage_rc(tid * 16 + i * 8192, R, C); const int Rb = Epi::PERM ? ((R & ~31) + perm32(R & 31)) : R;
        voffA[i] = (unsigned)(R * K + C) * 2u; voffB[i] = (unsigned)(Rb * K + C) * 2u; }
    const size_t kstep = (size_t)(BK * 2);
    const size_t hstep = (size_t)HALF * K * 2;
    const size_t tstep = 2 * hstep;
    const unsigned ldsw = (unsigned)wid * 1024u;
    const int aoff = lds_byte(wr * 64 + fr, fq * 8), boff = lds_byte(wc * 32 + fr, fq * 8);
#define PG8_SA(b, h) (((b) * 2 + (h)) * HTB)
#define PG8_SB(b, h) ((4 + (b) * 2 + (h)) * HTB)
#define PG8_STAGE(bufoff, gbase, voff) do { _Pragma("unroll") for (int _i = 0; _i < 2; ++_i) \
        __builtin_amdgcn_global_load_lds((const unsigned*)((const char*)(gbase) + (voff)[_i]), (PG8_LAS unsigned*)(lds + (bufoff) + ldsw + _i * 8192), 16, 0, 0); } while (0)
#define PG8_LDA(dst, b, h) do { _Pragma("unroll") for (int m = 0; m < 4; ++m) _Pragma("unroll") for (int k = 0; k < 2; ++k) dst[m][k] = *(const PG8_LAS bf16x8*)(lds + PG8_SA(b, h) + aoff + m * 2048 + k * 1024); } while (0)
#define PG8_LDB(dst, b, h) do { _Pragma("unroll") for (int n = 0; n < 2; ++n) _Pragma("unroll") for (int k = 0; k < 2; ++k) dst[n][k] = *(const PG8_LAS bf16x8*)(lds + PG8_SB(b, h) + boff + n * 2048 + k * 1024); } while (0)
#define PG8_MMA(ai, bj, At, Bt) do { __builtin_amdgcn_s_setprio(1); _Pragma("unroll") for (int m = 0; m < 4; ++m) _Pragma("unroll") for (int n = 0; n < 2; ++n) _Pragma("unroll") for (int k = 0; k < 2; ++k) \
        acc[ai][bj][m][n] = __builtin_amdgcn_mfma_f32_16x16x32_bf16(Bt[n][k], At[m][k], acc[ai][bj][m][n], 0, 0, 0); __builtin_amdgcn_s_setprio(0); } while (0)
#define PG8_WAIT_V(n) asm volatile("s_waitcnt vmcnt(" #n ")" ::: "memory")
#define PG8_WAIT_L(n) asm volatile("s_waitcnt lgkmcnt(" #n ")" ::: "memory")
#define PG8_BAR __builtin_amdgcn_s_barrier()
#define PG8_SCHED __builtin_amdgcn_sched_barrier(0)
    Unit cur, nxt; int ui = 0;
    if (!S.next(0, cur)) return;
    f32x4 acc[2][2][4][2];
#pragma unroll
    for (int a = 0; a < 2; ++a)
#pragma unroll
        for (int b = 0; b < 2; ++b)
#pragma unroll
            for (int m = 0; m < 4; ++m)
#pragma unroll
                for (int n = 0; n < 2; ++n) acc[a][b][m][n] = (f32x4){0.f, 0.f, 0.f, 0.f};
    bf16x8 At[4][2], B0[2][2], B1[2][2];
    const char* cA = (const char*)g.A + (size_t)cur.pm * tstep; const char* cB = (const char*)g.Bt + (size_t)cur.pn * tstep;
    S.a_ready(cur);
    if constexpr (SP2) {
        PG8_STAGE(PG8_SB(0, 0), cB, voffB); PG8_STAGE(PG8_SB(0, 1), cB + hstep, voffB); PG8_STAGE(PG8_SA(0, 0), cA, voffA); PG8_STAGE(PG8_SA(0, 1), cA + hstep, voffA);
        if (wr == 1) PG8_BAR;
        PG8_WAIT_V(2); PG8_BAR;
        PG8_STAGE(PG8_SB(1, 0), cB + kstep, voffB); PG8_STAGE(PG8_SA(1, 0), cA + kstep, voffA); PG8_STAGE(PG8_SB(1, 1), cB + hstep + kstep, voffB);
        PG8_WAIT_V(6); PG8_BAR;
    } else {
        PG8_STAGE(PG8_SB(0, 0), cB, voffB); PG8_STAGE(PG8_SA(0, 0), cA, voffA); PG8_STAGE(PG8_SB(0, 1), cB + hstep, voffB); PG8_STAGE(PG8_SA(0, 1), cA + hstep, voffA);
        if (wr == 1) PG8_BAR;
        PG8_WAIT_V(4); PG8_BAR;
        PG8_STAGE(PG8_SB(1, 0), cB + kstep, voffB); PG8_STAGE(PG8_SA(1, 0), cA + kstep, voffA); PG8_STAGE(PG8_SB(1, 1), cB + hstep + kstep, voffB);
        PG8_WAIT_V(6); PG8_BAR;
    }
    for (;;) {
        const bool has_next = S.next(ui + 1, nxt);
        const char* nA = has_next ? (const char*)g.A + (size_t)nxt.pm * tstep : cA; const char* nB = has_next ? (const char*)g.Bt + (size_t)nxt.pn * tstep : cB;
        for (int t = 0; t < nt; t += 2) {
            const bool last = (t == nt - 2);
            const char* a1 = cA + (size_t)(t + 1) * kstep;
            const char* a2 = last ? nA : cA + (size_t)(t + 2) * kstep; const char* b2 = last ? nB : cB + (size_t)(t + 2) * kstep;
            const char* a3 = a2 + kstep; const char* b3 = b2 + kstep;
            if (last && has_next) S.a_ready(nxt);
            if constexpr (SP2) {
            PG8_LDB(B0, 0, 0); PG8_LDB(B1, 0, 1); PG8_SCHED; PG8_LDA(At, 0, 0); PG8_STAGE(PG8_SA(1, 1), a1 + hstep, voffA);
            PG8_WAIT_V(8); PG8_WAIT_L(0); PG8_BAR; PG8_MMA(0, 0, At, B0); PG8_MMA(0, 1, At, B1); PG8_BAR; PG8_SCHED;
            PG8_LDA(At, 0, 1); PG8_STAGE(PG8_SB(0, 0), b2, voffB); PG8_STAGE(PG8_SB(0, 1), b2 + hstep, voffB); PG8_STAGE(PG8_SA(0, 0), a2, voffA);
            PG8_WAIT_V(8); PG8_WAIT_L(0); PG8_BAR; PG8_MMA(1, 0, At, B0); PG8_MMA(1, 1, At, B1); PG8_BAR; PG8_SCHED;
            PG8_LDB(B0, 1, 0); PG8_LDB(B1, 1, 1); PG8_SCHED; PG8_LDA(At, 1, 0); PG8_STAGE(PG8_SA(0, 1), a2 + hstep, voffA);
            PG8_WAIT_V(8); PG8_WAIT_L(0); PG8_BAR; PG8_MMA(0, 0, At, B0); PG8_MMA(0, 1, At, B1); PG8_BAR; PG8_SCHED;
            PG8_LDA(At, 1, 1); PG8_STAGE(PG8_SB(1, 0), b3, voffB); PG8_STAGE(PG8_SB(1, 1), b3 + hstep, voffB); PG8_STAGE(PG8_SA(1, 0), a3, voffA);
            PG8_WAIT_V(8); PG8_WAIT_L(0); PG8_BAR; PG8_MMA(1, 0, At, B0); PG8_MMA(1, 1, At, B1); PG8_BAR; PG8_SCHED;
            } else {
            PG8_LDB(B0, 0, 0); PG8_SCHED; PG8_LDA(At, 0, 0); PG8_STAGE(PG8_SA(1, 1), a1 + hstep, voffA);
            PG8_WAIT_L(8); PG8_BAR; PG8_WAIT_L(0); PG8_MMA(0, 0, At, B0); PG8_BAR; PG8_SCHED;
            PG8_LDB(B1, 0, 1); PG8_STAGE(PG8_SB(0, 0), b2, voffB);
            PG8_BAR; PG8_WAIT_L(0); PG8_MMA(0, 1, At, B1); PG8_BAR;
            PG8_LDA(At, 0, 1); PG8_STAGE(PG8_SA(0, 0), a2, voffA);
            PG8_BAR; PG8_WAIT_L(0); PG8_MMA(1, 0, At, B0); PG8_BAR; PG8_SCHED;
            PG8_STAGE(PG8_SB(0, 1), b2 + hstep, voffB);
            PG8_WAIT_V(6); PG8_BAR; PG8_MMA(1, 1, At, B1); PG8_BAR;
            PG8_LDB(B0, 1, 0); PG8_SCHED; PG8_LDA(At, 1, 0); PG8_STAGE(PG8_SA(0, 1), a2 + hstep, voffA);
            PG8_WAIT_L(8); PG8_BAR; PG8_WAIT_L(0); PG8_MMA(0, 0, At, B0); PG8_BAR; PG8_SCHED;
            PG8_LDB(B1, 1, 1); PG8_STAGE(PG8_SB(1, 0), b3, voffB);
            PG8_BAR; PG8_WAIT_L(0); PG8_MMA(0, 1, At, B1); PG8_BAR;
            PG8_LDA(At, 1, 1); PG8_STAGE(PG8_SA(1, 0), a3, voffA);
            PG8_BAR; PG8_WAIT_L(0); PG8_MMA(1, 0, At, B0); PG8_BAR; PG8_SCHED;
            PG8_STAGE(PG8_SB(1, 1), b3 + hstep, voffB);
            PG8_WAIT_V(6); PG8_BAR; PG8_MMA(1, 1, At, B1); PG8_BAR;
            }
        }
        if constexpr (ALIGN_EPI) { if (wr == 0) PG8_BAR; }
        if constexpr (!Epi::AFTER_DRAIN) { E(acc, cur, wr, wc, fr, fq); S.done(cur); }
        if (!has_next) break;
#pragma unroll
        for (int a = 0; a < 2; ++a)
#pragma unroll
            for (int b = 0; b < 2; ++b)
#pragma unroll
                for (int m = 0; m < 4; ++m)
#pragma unroll
                    for (int n = 0; n < 2; ++n) acc[a][b][m][n] = (f32x4){0.f, 0.f, 0.f, 0.f};
        cur = nxt; cA = nA; cB = nB; ++ui;
        if constexpr (ALIGN_EPI) { if (wr == 1) PG8_BAR; }
    }
    PG8_WAIT_V(0);
    if constexpr (!ALIGN_EPI) { if (wr == 0) PG8_BAR; }
    PG8_BAR;
    if constexpr (Epi::AFTER_DRAIN) { E.fused(acc, cur, wr, wc, fr, fq, lds, wid, lane); S.done(cur); }
#undef PG8_SA
#undef PG8_SB
#undef PG8_STAGE
#undef PG8_LDA
#undef PG8_LDB
#undef PG8_MMA
#undef PG8_WAIT_V
#undef PG8_WAIT_L
#undef PG8_BAR
#undef PG8_SCHED
}
}

#define LAS __attribute__((address_space(3)))
typedef unsigned short bf16;
typedef float f32x4 __attribute__((ext_vector_type(4)));
typedef unsigned u32x4 __attribute__((ext_vector_type(4)));
typedef unsigned u32x2 __attribute__((ext_vector_type(2)));
typedef short bf16x8 __attribute__((ext_vector_type(8)));
#define MFMA16(a, b, c) __builtin_amdgcn_mfma_f32_16x16x32_bf16((a), (b), (c), 0, 0, 0)

__device__ __forceinline__ float bf_lo(unsigned w) { return __uint_as_float(w << 16); }
__device__ __forceinline__ float bf_hi(unsigned w) { return __uint_as_float(w & 0xffff0000u); }
__device__ __forceinline__ unsigned pk2(float lo, float hi) { return pg8::cvt_pk_bf16(lo, hi); }
__device__ __forceinline__ float wave_sum(float v) {
#pragma unroll
    for (int o = 1; o < 64; o <<= 1) v += __shfl_xor(v, o);
    return v;
}
__device__ __forceinline__ void unpack8(const u32x4 w, float (&v)[8]) { v[0] = bf_lo(w.x); v[1] = bf_hi(w.x); v[2] = bf_lo(w.y); v[3] = bf_hi(w.y); v[4] = bf_lo(w.z); v[5] = bf_hi(w.z); v[6] = bf_lo(w.w); v[7] = bf_hi(w.w); }
__device__ __forceinline__ u32x4 pack8f(const float (&v)[8]) { u32x4 w; w.x = pk2(v[0], v[1]); w.y = pk2(v[2], v[3]); w.z = pk2(v[4], v[5]); w.w = pk2(v[6], v[7]); return w; }

struct Args { const float* in[27]; float* out; unsigned char* ws; int ph_lo, ph_hi; };

__device__ __forceinline__ void xpose_item(const float* W, int ldw, int K, int col0, bf16* WT, int row0, int kb, LAS float* scr, int lane) {
    const int k0 = 64 * kb;
#pragma unroll 8
    for (int i = 0; i < 32; ++i) { const int kk = 2 * i + (lane >> 5); scr[kk * 33 + (lane & 31)] = W[(size_t)(k0 + kk) * ldw + col0 + (lane & 31)]; }
    asm volatile("s_waitcnt lgkmcnt(0)" ::: "memory");
    const int c = lane & 7;
#pragma unroll
    for (int j = 0; j < 4; ++j) { const int n = (lane >> 3) + 8 * j; const LAS float* s = scr + (8 * c) * 33 + n;
        u32x4 o; o.x = pk2(s[0 * 33], s[1 * 33]); o.y = pk2(s[2 * 33], s[3 * 33]); o.z = pk2(s[4 * 33], s[5 * 33]); o.w = pk2(s[6 * 33], s[7 * 33]);
        *(u32x4*)(WT + (size_t)(row0 + n) * K + k0 + 8 * c) = o; }
    asm volatile("s_waitcnt lgkmcnt(0)" ::: "memory");
}
__device__ __forceinline__ void prologue_item(const Args& a, unsigned char* ws, int it, LAS float* scr, int lane) {
    const int l = it / 8320; int r = it % 8320; const int hl = l >> 1;
    const float* W = nullptr; int ldw = DM, K = DM, col0 = 0, row0 = 0, kb = 0; bf16* WT = nullptr;
    if (r < 512) { W = a.in[9] + (size_t)l * DM * DM; col0 = 32 * (r & 31); WT = (bf16*)(ws + WS_WQ) + (size_t)l * DM * DM; row0 = col0; kb = r >> 5; }
    else if (r < 1024) { r -= 512; W = a.in[10] + (size_t)l * DM * 2 * DM; ldw = 2 * DM; col0 = 32 * (r & 31); WT = (bf16*)(ws + WS_WK) + (size_t)l * DM * DM; row0 = col0; kb = r >> 5; }
    else if (r < 1536) { r -= 1024; W = a.in[10] + (size_t)l * DM * 2 * DM; ldw = 2 * DM; row0 = 32 * (r & 31); col0 = DM + row0; WT = (bf16*)(ws + WS_WVT) + (size_t)l * DM * DM; kb = r >> 5; }
    else if (r < 2048) { r -= 1536; W = a.in[11] + (size_t)l * DM * DM; col0 = 32 * (r & 31); WT = (bf16*)(ws + WS_WO) + (size_t)l * DM * DM; row0 = col0; kb = r >> 5; }
    else if (r < 4864) { r -= 2048;
        const int rb = r % 176; kb = r / 176; row0 = 32 * rb; col0 = ((row0 >> 7) & 1) * DFF + (row0 >> 8) * 128 + (row0 & 127);
        W = a.in[12] + (size_t)l * DM * 2 * DFF; ldw = 2 * DFF; WT = (bf16*)(ws + WS_WGU) + (size_t)l * 2 * DFF * DM; }
    else if (r < 6272) { r -= 4864; W = a.in[13] + (size_t)l * DFF * DM; K = DFF; col0 = 32 * (r & 31); WT = (bf16*)(ws + WS_WDN) + (size_t)l * DM * DFF; row0 = col0; kb = r >> 5; }
    else if ((l & 1) == 0) { r -= 6272;
        if (r < 1280) { const int rb = r % 80; kb = r / 80; row0 = 32 * rb;
            col0 = row0 < 1024 ? row0 : row0 + 520; W = a.in[14] + (size_t)hl * DM * 3080; ldw = 3080; WT = (bf16*)(ws + WS_WIN) + (size_t)hl * 2560 * DM; }
        else if (r < 1536) { r -= 1280; W = a.in[14] + (size_t)hl * DM * 3080; ldw = 3080; row0 = 32 * (r & 15); col0 = 1024 + row0; WT = (bf16*)(ws + WS_WV) + (size_t)hl * 512 * DM; kb = r >> 4; }
        else { r -= 1536; W = a.in[17] + (size_t)hl * DM * DM; col0 = 32 * (r & 31); WT = (bf16*)(ws + WS_WOUT) + (size_t)hl * DM * DM; row0 = col0; kb = r >> 5; }
    } else { r -= 6272;
        if (r < 1024) { W = a.in[18] + (size_t)hl * DM * 2 * DM; ldw = 2 * DM; col0 = 32 * (r & 63); WT = (bf16*)(ws + WS_CIN) + (size_t)hl * 2 * DM * DM; row0 = col0; kb = r >> 6; }
        else if (r < 1280) { r -= 1024;
            const int rb = r & 63; kb = r >> 6; row0 = 32 * rb; const int nb = row0 >> 9, w = row0 & 511, jj = w >> 8, bj = (w >> 7) & 1, j = w & 127;
            W = (bj ? a.in[23] : a.in[21]) + (size_t)hl * 4 * 65536 + (size_t)nb * 65536; ldw = 256; K = 256; col0 = jj * 128 + j; WT = (bf16*)(ws + WS_CG) + (size_t)hl * 2048 * 256; }
        else if (r < 1792) { r -= 1280; W = a.in[26] + (size_t)hl * DM * DM; col0 = 32 * (r & 31); WT = (bf16*)(ws + WS_COUT) + (size_t)hl * DM * DM; row0 = col0; kb = r >> 5; }
    }
    if (W) xpose_item(W, ldw, K, col0, WT, row0, kb, scr, lane);
}

__device__ __forceinline__ void row_phase(const float* xsrc, const bf16* yb, const float* g_post, float* xdst, const float* g_pre, bf16* hdst,
                                          const float* wf, const float* bfg, float* logf, int gw, int NGW, int lane) {
    for (int row = gw; row < MT; row += NGW) {
        const f32x4* xr = (const f32x4*)(xsrc + (size_t)row * DM) + lane;
        f32x4 v[4];
#pragma unroll
        for (int j = 0; j < 4; ++j) v[j] = xr[64 * j];
        if (yb) {
            const u32x2* yr = (const u32x2*)(yb + (size_t)row * DM) + lane; f32x4 y[4]; float s = 0.f;
#pragma unroll
            for (int j = 0; j < 4; ++j) { const u32x2 w = yr[64 * j]; y[j] = (f32x4){bf_lo(w.x), bf_hi(w.x), bf_lo(w.y), bf_hi(w.y)}; s += (y[j].x * y[j].x + y[j].y * y[j].y) + (y[j].z * y[j].z + y[j].w * y[j].w); }
            const float rstd = 1.0f / sqrtf(wave_sum(s) * (1.0f / DM) + EPS);
#pragma unroll
            for (int j = 0; j < 4; ++j) { const f32x4 g = ((const f32x4*)g_post)[lane + 64 * j]; v[j] = v[j] + (y[j] * rstd) * g; }
            f32x4* xo = (f32x4*)(xdst + (size_t)row * DM) + lane;
#pragma unroll
            for (int j = 0; j < 4; ++j) xo[64 * j] = v[j];
        }
        if (g_pre) {
            float s = 0.f;
#pragma unroll
            for (int j = 0; j < 4; ++j) s += (v[j].x * v[j].x + v[j].y * v[j].y) + (v[j].z * v[j].z + v[j].w * v[j].w);
            const float rstd = 1.0f / sqrtf(wave_sum(s) * (1.0f / DM) + EPS);
            u32x2* ho = (u32x2*)(hdst + (size_t)row * DM) + lane;
#pragma unroll
            for (int j = 0; j < 4; ++j) { const f32x4 g = ((const f32x4*)g_pre)[lane + 64 * j]; v[j] = (v[j] * rstd) * g; u32x2 w; w.x = pk2(v[j].x, v[j].y); w.y = pk2(v[j].z, v[j].w); if (hdst) ho[64 * j] = w; }
            if (wf) {
                float mine = 0.f;
#pragma unroll
                for (int i = 0; i < 8; ++i) { float d = 0.f;
#pragma unroll
                    for (int j = 0; j < 4; ++j) { const f32x4 w = ((const f32x4*)wf)[i * 256 + lane + 64 * j]; d += (v[j].x * w.x + v[j].y * w.y) + (v[j].z * w.z + v[j].w * w.w); }
                    d = wave_sum(d); if (lane == i) mine = d; }
                if (lane < 8) { const float z = mine + bfg[lane]; logf[(size_t)row * 8 + lane] = fminf(z, 0.f) - log1pf(__expf(-fabsf(z))); }
            }
        }
    }
}

__device__ __forceinline__ void fox_unit(LAS unsigned char* lds, const bf16* PROJ, const bf16* VT, const float* LOGF, bf16* Y, int b, int h, int qb, int tid, int wid, int lane) {
    LAS float* cumL = (LAS float*)lds;
    LAS float* wtot = (LAS float*)(lds + 8192);
    LAS unsigned char* Kl = lds + 8192 + 256;
    LAS unsigned char* Vl = Kl + 9216;
    const int fr = lane & 15, fq = lane >> 4;
    const int hi = (qb + 1) * 256;
    const size_t tok0 = (size_t)b * SEQ;
    __syncthreads();
    {
        float e[4]; float run = 0.f;
#pragma unroll
        for (int i = 0; i < 4; ++i) { const int idx = 4 * tid + i; const float v = (idx < hi) ? LOGF[(tok0 + idx) * 8 + h] : 0.f; run += v; e[i] = run; }
        float sc = run;
#pragma unroll
        for (int o = 1; o < 64; o <<= 1) { const float t = __shfl_up(sc, o); if (lane >= o) sc += t; }
        if (lane == 63) wtot[wid] = sc;
        __syncthreads();
        float off = sc - run;
        for (int w = 0; w < wid; ++w) off += wtot[w];
#pragma unroll
        for (int i = 0; i < 4; ++i) cumL[4 * tid + i] = -(off + e[i]) * LOG2E;
    }
    const int q0w = qb * 256 + wid * 32;
    bf16x8 qf[2][2];
#pragma unroll
    for (int g = 0; g < 2; ++g)
#pragma unroll
        for (int kk = 0; kk < 2; ++kk) qf[g][kk] = *(const bf16x8*)(PROJ + (tok0 + q0w + 16 * g + fr) * 2560 + h * 64 + kk * 32 + fq * 8);
    const int srow = tid >> 3, sch = tid & 7;
    const bf16* kg = PROJ + (tok0 + srow) * 2560 + 512 + h * 64 + sch * 8;
    const bf16* vg = VT + (size_t)(h * 64 + srow) * MT + tok0 + sch * 8;
    const int jj = sch & 3, slot0 = 32 * (sch >> 2) + 16 * (jj & 1) + 4 * (jj >> 1);
    u32x4 kreg = *(const u32x4*)kg, vreg = *(const u32x4*)vg;
    const int nkt = (qb + 1) * 4;
    float mrun[2] = {-1e30f, -1e30f}, lrun[2] = {0.f, 0.f};
    f32x4 o[2][4];
#pragma unroll
    for (int g = 0; g < 2; ++g)
#pragma unroll
        for (int n = 0; n < 4; ++n) o[g][n] = (f32x4){0.f, 0.f, 0.f, 0.f};
    const float C2 = 0.125f * LOG2E;
    for (int kt = 0; kt < nkt; ++kt) {
        __syncthreads();
        *(LAS u32x4*)(Kl + srow * 144 + sch * 16) = kreg;
        *(LAS u32x2*)(Vl + srow * 144 + slot0 * 2) = (u32x2){vreg.x, vreg.y};
        *(LAS u32x2*)(Vl + srow * 144 + (slot0 + 8) * 2) = (u32x2){vreg.z, vreg.w};
        __syncthreads();
        if (kt + 1 < nkt) { kreg = *(const u32x4*)(kg + (size_t)(kt + 1) * 64 * 2560); vreg = *(const u32x4*)(vg + (kt + 1) * 64); }
        const int key0 = kt * 64;
        if (key0 <= q0w + 31) {
            f32x4 s[2][4];
#pragma unroll
            for (int n = 0; n < 4; ++n) {
                const bf16x8 k0 = *(const LAS bf16x8*)(Kl + (16 * n + fr) * 144 + fq * 16), k1 = *(const LAS bf16x8*)(Kl + (16 * n + fr) * 144 + 64 + fq * 16);
#pragma unroll
                for (int g = 0; g < 2; ++g) { s[g][n] = MFMA16(k0, qf[g][0], ((f32x4){0.f, 0.f, 0.f, 0.f})); s[g][n] = MFMA16(k1, qf[g][1], s[g][n]); }
            }
            const bool diag = key0 + 63 > q0w;
#pragma unroll
            for (int n = 0; n < 4; ++n) { const f32x4 cb = *(const LAS f32x4*)(cumL + key0 + 16 * n + 4 * fq);
#pragma unroll
                for (int g = 0; g < 2; ++g)
#pragma unroll
                    for (int e = 0; e < 4; ++e) { float v = s[g][n][e] * C2 + cb[e]; if (diag && (key0 + 16 * n + 4 * fq + e > q0w + 16 * g + fr)) v = -1e30f; s[g][n][e] = v; } }
            bf16x8 pf[2][2];
#pragma unroll
            for (int g = 0; g < 2; ++g) {
                float mx = -1e30f;
#pragma unroll
                for (int n = 0; n < 4; ++n) mx = fmaxf(mx, fmaxf(fmaxf(s[g][n][0], s[g][n][1]), fmaxf(s[g][n][2], s[g][n][3])));
                mx = fmaxf(mx, __shfl_xor(mx, 16)); mx = fmaxf(mx, __shfl_xor(mx, 32));
                const float mnew = fmaxf(mrun[g], mx), alpha = __builtin_amdgcn_exp2f(mrun[g] - mnew); mrun[g] = mnew;
                float rs = 0.f;
#pragma unroll
                for (int n = 0; n < 4; ++n)
#pragma unroll
                    for (int e = 0; e < 4; ++e) { const float p = __builtin_amdgcn_exp2f(s[g][n][e] - mnew); s[g][n][e] = p; rs += p; }
                lrun[g] = lrun[g] * alpha + rs;
#pragma unroll
                for (int n = 0; n < 4; ++n) o[g][n] = o[g][n] * alpha;
#pragma unroll
                for (int c = 0; c < 2; ++c) { const u32x4 w = pg8::pack8(s[g][2 * c], s[g][2 * c + 1]); pf[g][c] = __builtin_bit_cast(bf16x8, w); }
            }
#pragma unroll
            for (int n = 0; n < 4; ++n)
#pragma unroll
                for (int c = 0; c < 2; ++c) { const bf16x8 vf = *(const LAS bf16x8*)(Vl + (16 * n + fr) * 144 + c * 64 + fq * 16);
#pragma unroll
                    for (int g = 0; g < 2; ++g) o[g][n] = MFMA16(vf, pf[g][c], o[g][n]); }
        }
    }
#pragma unroll
    for (int g = 0; g < 2; ++g) {
        float l = lrun[g]; l += __shfl_xor(l, 16); l += __shfl_xor(l, 32);
        const float inv = 1.0f / l;
        bf16* yr = Y + (tok0 + q0w + 16 * g + fr) * DM + h * 64 + 4 * fq;
#pragma unroll
        for (int n = 0; n < 4; ++n) { u32x2 w; w.x = pk2(o[g][n][0] * inv, o[g][n][1] * inv); w.y = pk2(o[g][n][2] * inv, o[g][n][3] * inv); *(u32x2*)(yr + 16 * n) = w; }
    }
}

__device__ __forceinline__ void shortconv_items(const bf16* PROJ, const float* cw, bf16* Y, int gtid, int gthreads) {
    for (int it = gtid; it < (MT / 8) * 64; it += gthreads) {
        const int rb = it >> 6, c0 = (it & 63) * 8, t0 = rb * 8;
        float w0[8], w1[8], w2[8], p2[8], p1[8];
#pragma unroll
        for (int j = 0; j < 8; ++j) { w0[j] = cw[c0 + j]; w1[j] = cw[512 + c0 + j]; w2[j] = cw[1024 + c0 + j]; p2[j] = 0.f; p1[j] = 0.f; }
        if ((t0 & (SEQ - 1)) != 0) {
            float cv[8], uv[8];
            unpack8(*(const u32x4*)(PROJ + (size_t)(t0 - 2) * 2560 + 1536 + c0), cv); unpack8(*(const u32x4*)(PROJ + (size_t)(t0 - 2) * 2560 + 2048 + c0), uv);
#pragma unroll
            for (int j = 0; j < 8; ++j) p2[j] = cv[j] * uv[j];
            unpack8(*(const u32x4*)(PROJ + (size_t)(t0 - 1) * 2560 + 1536 + c0), cv); unpack8(*(const u32x4*)(PROJ + (size_t)(t0 - 1) * 2560 + 2048 + c0), uv);
#pragma unroll
            for (int j = 0; j < 8; ++j) p1[j] = cv[j] * uv[j];
        }
#pragma unroll
        for (int r = 0; r < 8; ++r) { const bf16* rowp = PROJ + (size_t)(t0 + r) * 2560;
            float bv[8], cv[8], uv[8], yv[8];
            unpack8(*(const u32x4*)(rowp + 1024 + c0), bv); unpack8(*(const u32x4*)(rowp + 1536 + c0), cv); unpack8(*(const u32x4*)(rowp + 2048 + c0), uv);
#pragma unroll
            for (int j = 0; j < 8; ++j) { const float cu = cv[j] * uv[j]; yv[j] = bv[j] * (w0[j] * p2[j] + w1[j] * p1[j] + w2[j] * cu); p2[j] = p1[j]; p1[j] = cu; }
            *(u32x4*)(Y + (size_t)(t0 + r) * DM + 512 + c0) = pack8f(yv); }
    }
}
__device__ __forceinline__ void lruconv_items(const bf16* U, const float* cw, const float* cb, bf16* UC, int gtid, int gthreads) {
    for (int it = gtid; it < (MT / 8) * 128; it += gthreads) {
        const int rb = it >> 7, c0 = (it & 127) * 8, t0 = rb * 8;
        float w0[8], w1[8], w2[8], w3[8], bb[8], p3[8], p2[8], p1[8];
#pragma unroll
        for (int j = 0; j < 8; ++j) { w0[j] = cw[c0 + j]; w1[j] = cw[1024 + c0 + j]; w2[j] = cw[2048 + c0 + j]; w3[j] = cw[3072 + c0 + j]; bb[j] = cb[c0 + j]; p3[j] = 0.f; p2[j] = 0.f; p1[j] = 0.f; }
        if ((t0 & (SEQ - 1)) != 0) { unpack8(*(const u32x4*)(U + (size_t)(t0 - 3) * 2 * DM + c0), p3); unpack8(*(const u32x4*)(U + (size_t)(t0 - 2) * 2 * DM + c0), p2); unpack8(*(const u32x4*)(U + (size_t)(t0 - 1) * 2 * DM + c0), p1); }
        bf16* dst = UC + ((size_t)(c0 >> 8) * MT + t0) * 256 + (c0 & 255);
#pragma unroll
        for (int r = 0; r < 8; ++r) { float uv[8], yv[8]; unpack8(*(const u32x4*)(U + (size_t)(t0 + r) * 2 * DM + c0), uv);
#pragma unroll
            for (int j = 0; j < 8; ++j) { yv[j] = w0[j] * p3[j] + w1[j] * p2[j] + w2[j] * p1[j] + w3[j] * uv[j] + bb[j]; p3[j] = p2[j]; p2[j] = p1[j]; p1[j] = uv[j]; }
            *(u32x4*)(dst + (size_t)r * 256) = pack8f(yv); }
    }
}
__device__ __forceinline__ void scan_item(LAS unsigned char* lds, const bf16* LA, const bf16* BB, const bf16* GT, bf16* Y, int item, int tid) {
    LAS float* sA = (LAS float*)lds; LAS float* sH = sA + 2048; LAS float* sC = sH + 2048;
    const int b = item >> 5, c0 = (item & 31) * 32 + (tid & 7) * 4, tc = tid >> 3;
    const size_t row0 = (size_t)b * SEQ + tc * 32;
    float A[4] = {1.f, 1.f, 1.f, 1.f}, Hh[4] = {0.f, 0.f, 0.f, 0.f};
#pragma unroll 8
    for (int r = 0; r < 32; ++r) { const u32x2 lw = *(const u32x2*)(LA + (row0 + r) * 2 * DM + c0), bw = *(const u32x2*)(BB + (row0 + r) * DM + c0);
        const float la[4] = {bf_lo(lw.x), bf_hi(lw.x), bf_lo(lw.y), bf_hi(lw.y)}, bv[4] = {bf_lo(bw.x), bf_hi(bw.x), bf_lo(bw.y), bf_hi(bw.y)};
#pragma unroll
        for (int j = 0; j < 4; ++j) { const float a = __expf(la[j]); Hh[j] = a * Hh[j] + bv[j]; A[j] *= a; } }
    __syncthreads();
#pragma unroll
    for (int j = 0; j < 4; ++j) { sA[tc * 32 + (tid & 7) * 4 + j] = A[j]; sH[tc * 32 + (tid & 7) * 4 + j] = Hh[j]; }
    __syncthreads();
    if (tid < 32) { float carry = 0.f; for (int t = 0; t < 64; ++t) { sC[t * 32 + tid] = carry; carry = sA[t * 32 + tid] * carry + sH[t * 32 + tid]; } }
    __syncthreads();
    float hc[4];
#pragma unroll
    for (int j = 0; j < 4; ++j) hc[j] = sC[tc * 32 + (tid & 7) * 4 + j];
#pragma unroll 8
    for (int r = 0; r < 32; ++r) { const u32x2 lw = *(const u32x2*)(LA + (row0 + r) * 2 * DM + c0), bw = *(const u32x2*)(BB + (row0 + r) * DM + c0), gw2 = *(const u32x2*)(GT + (row0 + r) * 2 * DM + c0);
        const float la[4] = {bf_lo(lw.x), bf_hi(lw.x), bf_lo(lw.y), bf_hi(lw.y)}, bv[4] = {bf_lo(bw.x), bf_hi(bw.x), bf_lo(bw.y), bf_hi(bw.y)}, gv[4] = {bf_lo(gw2.x), bf_hi(gw2.x), bf_lo(gw2.y), bf_hi(gw2.y)};
        float yv[4];
#pragma unroll
        for (int j = 0; j < 4; ++j) { hc[j] = __expf(la[j]) * hc[j] + bv[j]; const float x = gv[j], u = 0.7978845608f * (x + 0.044715f * x * x * x);
            yv[j] = x * __builtin_amdgcn_rcpf(1.0f + __expf(-2.0f * u)) * hc[j]; }
        u32x2 w; w.x = pk2(yv[0], yv[1]); w.y = pk2(yv[2], yv[3]); *(u32x2*)(Y + (row0 + r) * DM + c0) = w; }
}

__device__ __forceinline__ void cross_unit(LAS unsigned char* lds, const bf16* Q, const bf16* MK, const bf16* MVT, bf16* Y, int b, int h, int rb, int tid, int wid, int lane) {
    const int fr = lane & 15, fq = lane >> 4;
    const size_t tokw = (size_t)b * SEQ + rb * 256 + wid * 32;
    u32x4 pre[4];
#define CROSS_LOAD(st) do { int tl_ = tid; asm volatile("" : "+v"(tl_)); if ((st) < 4) { _Pragma("unroll") for (int i = 0; i < 4; ++i) { const int idx = tl_ + 512 * i, row = idx >> 3, ch = idx & 7; \
            pre[i] = *(const u32x4*)(MK + (size_t)(b * MEML + row) * DM + h * 256 + (st) * 64 + ch * 8); } } \
        else { _Pragma("unroll") for (int i = 0; i < 4; ++i) { const int idx = tl_ + 512 * i, d = idx >> 5, j = idx & 31; \
            pre[i] = *(const u32x4*)(MVT + (size_t)(h * 256 + ((st) - 4) * 64 + d) * 2048 + b * MEML + j * 8); } } } while (0)
#define CROSS_STORE(st) do { int tl_ = tid; asm volatile("" : "+v"(tl_)); if ((st) < 4) { _Pragma("unroll") for (int i = 0; i < 4; ++i) { const int idx = tl_ + 512 * i, row = idx >> 3, ch = idx & 7; *(LAS u32x4*)(lds + row * 144 + ch * 16) = pre[i]; } } \
        else { _Pragma("unroll") for (int i = 0; i < 4; ++i) { const int idx = tl_ + 512 * i, d = idx >> 5, j = idx & 31, jj = j & 3, slot0 = 32 * (j >> 2) + 16 * (jj & 1) + 4 * (jj >> 1); \
            *(LAS u32x2*)(lds + d * 528 + slot0 * 2) = (u32x2){pre[i].x, pre[i].y}; *(LAS u32x2*)(lds + d * 528 + (slot0 + 8) * 2) = (u32x2){pre[i].z, pre[i].w}; } } } while (0)
    CROSS_LOAD(0);
    f32x4 s[2][16];
#pragma unroll
    for (int g = 0; g < 2; ++g)
#pragma unroll
        for (int n = 0; n < 16; ++n) s[g][n] = (f32x4){0.f, 0.f, 0.f, 0.f};
    for (int dc = 0; dc < 4; ++dc) {
        __syncthreads(); CROSS_STORE(0); __syncthreads();
        CROSS_LOAD(dc + 1);
        bf16x8 qf[2][2];
#pragma unroll
        for (int g = 0; g < 2; ++g)
#pragma unroll
            for (int kk = 0; kk < 2; ++kk) qf[g][kk] = *(const bf16x8*)(Q + (tokw + 16 * g + fr) * DM + h * 256 + dc * 64 + kk * 32 + fq * 8);
#pragma unroll
        for (int n = 0; n < 16; ++n) {
            const bf16x8 k0 = *(const LAS bf16x8*)(lds + (16 * n + fr) * 144 + fq * 16), k1 = *(const LAS bf16x8*)(lds + (16 * n + fr) * 144 + 64 + fq * 16);
#pragma unroll
            for (int g = 0; g < 2; ++g) { s[g][n] = MFMA16(k0, qf[g][0], s[g][n]); s[g][n] = MFMA16(k1, qf[g][1], s[g][n]); }
        }
    }
    bf16x8 pf[2][8]; float inv[2];
    const float SC = 0.0625f * LOG2E;
#pragma unroll
    for (int g = 0; g < 2; ++g) {
        float mx = -1e30f;
#pragma unroll
        for (int n = 0; n < 16; ++n) mx = fmaxf(mx, fmaxf(fmaxf(s[g][n][0], s[g][n][1]), fmaxf(s[g][n][2], s[g][n][3])));
        mx = fmaxf(mx, __shfl_xor(mx, 16)); mx = fmaxf(mx, __shfl_xor(mx, 32));
        const float mb = mx * SC;
        float rs = 0.f;
#pragma unroll
        for (int c = 0; c < 8; ++c) { f32x4 p0, p1;
#pragma unroll
            for (int e = 0; e < 4; ++e) { p0[e] = __builtin_amdgcn_exp2f(s[g][2 * c][e] * SC - mb); p1[e] = __builtin_amdgcn_exp2f(s[g][2 * c + 1][e] * SC - mb); }
            rs += (p0[0] + p0[1]) + (p0[2] + p0[3]) + (p1[0] + p1[1]) + (p1[2] + p1[3]);
            const u32x4 w = pg8::pack8(p0, p1); pf[g][c] = __builtin_bit_cast(bf16x8, w); }
        rs += __shfl_xor(rs, 16); rs += __shfl_xor(rs, 32); inv[g] = 1.0f / rs;
        asm volatile("" ::: "memory");
    }
    for (int dc = 0; dc < 4; ++dc) {
        __syncthreads(); CROSS_STORE(4); __syncthreads();
        if (dc + 1 < 4) CROSS_LOAD(dc + 5);
        f32x4 o[2][4];
#pragma unroll
        for (int g = 0; g < 2; ++g)
#pragma unroll
            for (int n = 0; n < 4; ++n) o[g][n] = (f32x4){0.f, 0.f, 0.f, 0.f};
#pragma unroll
        for (int n = 0; n < 4; ++n)
#pragma unroll
            for (int c = 0; c < 8; ++c) { const bf16x8 vf = *(const LAS bf16x8*)(lds + (16 * n + fr) * 528 + c * 64 + fq * 16);
#pragma unroll
                for (int g = 0; g < 2; ++g) o[g][n] = MFMA16(vf, pf[g][c], o[g][n]); }
#pragma unroll
        for (int g = 0; g < 2; ++g) { bf16* yr = Y + (tokw + 16 * g + fr) * DM + h * 256 + dc * 64 + 4 * fq;
#pragma unroll
            for (int n = 0; n < 4; ++n) { u32x2 w; w.x = pk2(o[g][n][0] * inv[g], o[g][n][1] * inv[g]); w.y = pk2(o[g][n][2] * inv[g], o[g][n][3] * inv[g]); *(u32x2*)(yr + 16 * n) = w; } }
    }
#undef CROSS_LOAD
#undef CROSS_STORE
}

#define XB_TMO      128
#define XB_XCNT(j)  (256  + 64 * (j))
#define XB_XSUB(j)  (1280 + 64 * (j))
#define XB_XGEN(j)  (2304 + 64 * (j))
#define XB_TOP      3328
#define XB_TOPGEN   3392
#define XCD_BAR_WORDS 3456
#define XB_SPIN_CAP (1u << 18)

__device__ __forceinline__ unsigned xb_ld(unsigned* p)              { return __hip_atomic_load(p, __ATOMIC_RELAXED, __HIP_MEMORY_SCOPE_AGENT); }
__device__ __forceinline__ unsigned xb_add(unsigned* p, unsigned v) { return __hip_atomic_fetch_add(p, v, __ATOMIC_RELAXED, __HIP_MEMORY_SCOPE_AGENT); }
__device__ __forceinline__ unsigned xb_xcc_id() { return (unsigned)__builtin_amdgcn_s_getreg((3 << 11) | 20) & 0xFu; }
#define XB_SPIN(cond, bar) do { unsigned _sp = 0; while (cond) { __builtin_amdgcn_s_sleep(1); \
    if ((++_sp & 255u) == 0u) { if (xb_ld(&(bar)[XB_TMO])) break; if (_sp > XB_SPIN_CAP) { atomicAdd(&(bar)[XB_TMO], 1u); break; } } } } while (0)

struct XcdBarrier {
    unsigned* bar; unsigned x;
    volatile LAS unsigned* st;
};

__device__ __forceinline__ XcdBarrier xcd_barrier_post(unsigned* bar, volatile LAS unsigned* st) {
    XcdBarrier b; b.bar = bar; b.x = xb_xcc_id(); b.st = st;
    if (threadIdx.x == 0) (void)xb_add(&bar[XB_XCNT(b.x)], 1u);
    return b;
}
__device__ __forceinline__ void xcd_barrier_complete(unsigned* bar, unsigned x, unsigned& nloc, unsigned& nx) {
    const unsigned G = gridDim.x * gridDim.y * gridDim.z;
    unsigned sum, cnt, mine, sp = 0u;
    for (;;) {
        sum = 0u; cnt = 0u; mine = 0u;
#pragma unroll
        for (unsigned j = 0; j < 16; ++j) { const unsigned c = xb_ld(&bar[XB_XCNT(j)]); sum += c; cnt += (c > 0u) ? 1u : 0u; mine = (j == x) ? c : mine; }
        if (sum == G) break;
        __builtin_amdgcn_s_sleep(1);
        if ((++sp & 255u) == 0u) { if (xb_ld(&bar[XB_TMO])) break; if (sp > XB_SPIN_CAP) { atomicAdd(&bar[XB_TMO], 1u); break; } }
    }
    nloc = mine > 0u ? mine : 1u; nx = cnt > 0u ? cnt : 1u;
}

__device__ __forceinline__ void xcd_barrier(const XcdBarrier& b) {
    asm volatile("s_waitcnt vmcnt(0)" ::: "memory");
    __syncthreads();
    if (threadIdx.x == 0) {
        unsigned* bar = b.bar;
        __builtin_amdgcn_s_waitcnt(0);
        unsigned nloc = b.st[0], nx = b.st[1];
        if (nloc == 0u) { xcd_barrier_complete(bar, b.x, nloc, nx); b.st[0] = nloc; b.st[1] = nx; }
        const unsigned old = xb_add(&bar[XB_XSUB(b.x)], 1u);
        const unsigned gen = old / nloc;
        if (old + 1u == (gen + 1u) * nloc) {
            __builtin_amdgcn_fence(__ATOMIC_RELEASE, "agent");
            asm volatile("s_waitcnt vmcnt(0)" ::: "memory");
            const unsigned og = xb_add(&bar[XB_TOP], 1u);
            const unsigned tg = og / nx;
            if (og + 1u == (tg + 1u) * nx) xb_add(&bar[XB_TOPGEN], 1u);
            else XB_SPIN(xb_ld(&bar[XB_TOPGEN]) == tg, bar);
            __builtin_amdgcn_fence(__ATOMIC_ACQUIRE, "agent");
            xb_add(&bar[XB_XGEN(b.x)], 1u);
            asm volatile("s_waitcnt vmcnt(0)" ::: "memory");
        } else {
            XB_SPIN(xb_ld(&bar[XB_XGEN(b.x)]) == gen, bar);
            __builtin_amdgcn_fence(__ATOMIC_ACQUIRE, "agent");
            asm volatile("s_waitcnt vmcnt(0)" ::: "memory");
        }
    }
    __syncthreads();
}

struct GD { const bf16* A; const bf16* Bt; int nM, nN, nwg, K, omode, emode, coff; bf16* O; int ldc; };
__device__ __forceinline__ GD gd_plain(const bf16* A, const bf16* Bt, int M, int N, int K, bf16* O, int ldc) {
    GD d{}; d.A = A; d.Bt = Bt; d.nM = M / 256; d.nN = N / 256; d.nwg = d.nM * d.nN; d.K = K; d.O = O; d.ldc = ldc; return d; }
enum { OP_NONE = 0, OP_PRO, OP_FOX, OP_ROW, OP_CROSS, OP_LRUCONV, OP_SCAN };

__global__ void __launch_bounds__(512, 2) hybrid_fwd(Args a) {
    extern __shared__ __attribute__((aligned(16))) unsigned char lds_raw[];
    LAS unsigned char* lds = (LAS unsigned char*)lds_raw;
    const int G = gridDim.x, bx = blockIdx.x, NGW = G * 8;
    volatile LAS unsigned* bst = (volatile LAS unsigned*)(lds + 131072 + 320);
    if (threadIdx.x < 2) bst[threadIdx.x] = 0u;
    __syncthreads();
    const XcdBarrier xbar = xcd_barrier_post((unsigned*)(a.ws + WS_BAR), bst);

    for (int ph = a.ph_lo; ph < a.ph_hi; ++ph) {
        unsigned char* ws = a.ws; asm volatile("" : "+s"(ws));
        bf16* const H = (bf16*)(ws + WS_H); bf16* const PROJ = (bf16*)(ws + WS_PROJ); bf16* const Yb = (bf16*)(ws + WS_Y);
        float* const LOGF = (float*)(ws + WS_LOGF); float* const WF = (float*)(ws + WS_WF); float* const SPT = (float*)(ws + WS_SP);
        float* const X = a.out;
        int n0 = 0, op = OP_NONE;
        int l = 0, code = -1;
        if (ph == 0) op = OP_PRO;
        else { const int pp = (ph - 1) % 24, pair = (ph - 1) / 24; if (pp < 11) { l = 2 * pair; code = pp; } else { l = 2 * pair + 1; code = 16 + (pp - 11); } }
        const int hl = l >> 1;
        switch (code) {
        case 0: n0 = (l == 0) ? 3 : 2; if (l == 0) op = OP_ROW; break;
        case 1: op = OP_FOX; break;
        case 17: op = OP_LRUCONV; break;
        case 19: op = OP_SCAN; break;
        case 5: case 23: op = OP_CROSS; break;
        case 3: case 21: case 7: case 25: case 10: case 28: op = OP_ROW; break;
        default: n0 = 1; break;
        }
#ifndef NO_G0
#ifdef DUP_GEMM
        for (int rep_ = 0; rep_ < 2; ++rep_)
#endif
        for (int gi = 0; gi < n0; ++gi) {
            GD g{};
            switch (code) {
            case 0:
                if (gi == 0) g = gd_plain(H, (const bf16*)(ws + WS_WIN) + (size_t)hl * 2560 * DM, MT, 2560, DM, PROJ, 2560);
                else if (gi == 1) { g = gd_plain((const bf16*)(ws + WS_WV) + (size_t)hl * 512 * DM, H, 512, MT, DM, PROJ + (size_t)MT * 2560, MT); g.coff = G / 2; }
                else { g.A = (const bf16*)ws; g.Bt = (const bf16*)ws; g.nwg = 256; g.K = DM; g.omode = 2; g.emode = 1; g.O = (bf16*)(ws + WS_MEMK); }
                break;
            case 2: g = gd_plain(Yb, (const bf16*)(ws + WS_WOUT) + (size_t)hl * DM * DM, MT, DM, DM, H, DM); break;
            case 16: g = gd_plain(H, (const bf16*)(ws + WS_CIN) + (size_t)hl * 2 * DM * DM, MT, 2 * DM, DM, PROJ, 2 * DM); break;
            case 18:
                g.A = PROJ + (size_t)2 * MT * DM; g.Bt = (const bf16*)(ws + WS_CG) + (size_t)hl * 2048 * 256; g.nwg = 512; g.K = 256; g.omode = 1; g.emode = 3;
                g.O = PROJ + DM; g.ldc = hl; break;
            case 20: g = gd_plain(Yb, (const bf16*)(ws + WS_COUT) + (size_t)hl * DM * DM, MT, DM, DM, H, DM); break;
            case 4: case 22: g = gd_plain(H, (const bf16*)(ws + WS_WQ) + (size_t)l * DM * DM, MT, DM, DM, PROJ, DM); break;
            case 6: case 24: g = gd_plain(Yb, (const bf16*)(ws + WS_WO) + (size_t)l * DM * DM, MT, DM, DM, H, DM); break;
            case 8: case 26: g = gd_plain(H, (const bf16*)(ws + WS_WGU) + (size_t)l * 2 * DFF * DM, MT, 2 * DFF, DM, PROJ, DFF); g.emode = 2; break;
            default: g = gd_plain(PROJ, (const bf16*)(ws + WS_WDN) + (size_t)l * DM * DFF, MT, DM, DFF, H, DM); break;
            }
            pg8::Gemm gg{g.A, g.Bt, 0, 0, g.K};
            pg8::GenOrder S{g.omode, g.nM, g.nN, g.nwg, G, (bx + g.coff) % G};
            pg8::EpiAll E{g.emode, g.O, g.ldc};
            pg8::gemm_phase<pg8::EpiAll, pg8::GenOrder, true, true>(lds, gg, S, E);
        }
#endif
        const float* r_g_post = nullptr; const float* r_g_pre = nullptr; const float* r_xsrc = X; const float* r_wf = nullptr; const float* r_bf = nullptr;
        const bf16* r_y = H; bf16* r_h = H;
        switch (code) {
        case 0: r_xsrc = a.in[0]; r_y = nullptr; r_g_pre = a.in[2]; r_h = nullptr; r_wf = WF; r_bf = a.in[15]; break;
        case 3: case 21: r_g_post = a.in[3] + l * DM; r_g_pre = a.in[4] + l * DM; if (l == 0) r_xsrc = a.in[0]; break;
        case 7: case 25: r_g_post = a.in[6] + l * DM; r_g_pre = a.in[7] + l * DM; break;
        case 10: case 28:
            r_g_post = a.in[8] + l * DM;
            if (l != 3) { r_g_pre = a.in[2] + (l + 1) * DM; if (l & 1) { r_wf = WF + (size_t)((l + 1) >> 1) * 8 * DM; r_bf = a.in[15] + ((l + 1) >> 1) * 8; } }
            break;
        default: break;
        }
        int tid = threadIdx.x; asm volatile("" : "+v"(tid));
        const int lane = tid & 63, wid = __builtin_amdgcn_readfirstlane(tid >> 6), gw = bx * 8 + wid;
#ifdef DUP_OPS
        for (int rep_ = 0; rep_ < ((DUP_OPS >> op) & 1) + 1; ++rep_) {
#endif
        if (false) {}
#ifndef NO_PRO
        else if (op == OP_PRO) {
            LAS float* scr = (LAS float*)(lds + wid * 16384);
            for (int it = gw; it < 4 * 8320; it += NGW) prologue_item(a, ws, it, scr, lane);
            for (int idx = bx * 512 + tid; idx < 2 * 8 * DM; idx += G * 512) { const int e = idx >> 13, i = (idx >> 10) & 7, k = idx & 1023; WF[idx] = a.in[14][(size_t)e * DM * 3080 + (size_t)k * 3080 + 1536 + i]; }
            for (int idx = bx * 512 + tid; idx < 2 * DM; idx += G * 512) { const int o = idx >> 10, c = idx & 1023; const float z = -a.in[25][idx];
                SPT[o * 3 * DM + c] = a.in[22][idx]; SPT[o * 3 * DM + DM + c] = a.in[24][idx]; SPT[o * 3 * DM + 2 * DM + c] = -8.0f * (fmaxf(z, 0.f) + log1pf(__expf(-fabsf(z)))); }
            for (int row = gw; row < NB * MEML; row += NGW) {
                const f32x4* xr = (const f32x4*)(a.in[1] + (size_t)row * DM) + lane; f32x4 v[4]; float s = 0.f;
#pragma unroll
                for (int j = 0; j < 4; ++j) { v[j] = xr[64 * j]; s += (v[j].x * v[j].x + v[j].y * v[j].y) + (v[j].z * v[j].z + v[j].w * v[j].w); }
                const float rstd = 1.0f / sqrtf(wave_sum(s) * (1.0f / DM) + EPS);
                for (int ll = 0; ll < 4; ++ll) { u32x2* ho = (u32x2*)(Yb + ((size_t)ll * NB * MEML + row) * DM) + lane;
#pragma unroll
                    for (int j = 0; j < 4; ++j) { const f32x4 g = ((const f32x4*)(a.in[5] + ll * DM))[lane + 64 * j]; const f32x4 t = (v[j] * rstd) * g; u32x2 w; w.x = pk2(t.x, t.y); w.y = pk2(t.z, t.w); ho[64 * j] = w; } }
            }
            row_phase(a.in[0], nullptr, nullptr, nullptr, a.in[2], H, nullptr, nullptr, nullptr, gw, NGW, lane);
        }
#endif
#ifndef NO_FOX
        else if (op == OP_FOX) {
            const bf16* VT = PROJ + (size_t)MT * 2560;
            if (G == 256) { const int bh = bx >> 2, s4 = bx & 3;
                for (int i = 0; i < 2; ++i) fox_unit(lds, PROJ, VT, LOGF, Yb, bh >> 3, bh & 7, i ? 7 - s4 : s4, tid, wid, lane); }
            else { for (int u = bx; u < 512; u += G) fox_unit(lds, PROJ, VT, LOGF, Yb, u >> 6, (u >> 3) & 7, u & 7, tid, wid, lane); }
            shortconv_items(PROJ, a.in[16] + (size_t)hl * 3 * 512, Yb, bx * 512 + tid, G * 512);
        }
#endif
#ifndef NO_ROW
        else if (op == OP_ROW) {
            row_phase(r_xsrc, r_y, r_g_post, X, r_g_pre, r_h, r_wf, r_bf, LOGF, gw, NGW, lane);
        }
#endif
#ifndef NO_CROSS
        else if (op == OP_CROSS) {
            for (int u = bx; u < 256; u += G) { cross_unit(lds, PROJ, (const bf16*)(ws + WS_MEMK) + (size_t)l * 2048 * DM, (const bf16*)(ws + WS_MEMVT) + (size_t)l * 2048 * DM, Yb, u >> 5, (u >> 3) & 3, u & 7, tid, wid, lane); __syncthreads(); }
        }
#endif
#ifndef NO_LRUCONV
        else if (op == OP_LRUCONV) {
            lruconv_items(PROJ + DM, a.in[19] + (size_t)hl * 4 * DM, a.in[20] + (size_t)hl * DM, PROJ + (size_t)2 * MT * DM, bx * 512 + tid, G * 512);
        }
#endif
#ifndef NO_SCAN
        else if (op == OP_SCAN) {
            for (int it = bx; it < 256; it += G) scan_item(lds, PROJ + DM, H, PROJ, Yb, it, tid);
        }
#endif
#ifdef DUP_OPS
        }
#endif
        if (ph + 1 < a.ph_hi) { if (ph == 0) cg::this_grid().sync(); else xcd_barrier(xbar); }
#ifdef DUP_SYNC
        if (ph + 1 < a.ph_hi) xcd_barrier(xbar);
#endif
    }
}

extern "C" void kernel_launch(void* const* d_in, const int* in_sizes, int n_in, void* d_out, int out_size, void* d_ws, size_t ws_size, hipStream_t stream) {
    static int grid = 0;
    if (grid == 0) {
        if (n_in != 27 || out_size != MT * DM || ws_size < WS_END) { fprintf(stderr, "kernel_launch: unexpected shapes (n_in %d, out %d, ws %zu)\n", n_in, out_size, ws_size); grid = -1; return; }
        int dev = 0, cus = 0, per_cu = 0;
        (void)hipGetDevice(&dev); (void)hipDeviceGetAttribute(&cus, hipDeviceAttributeMultiprocessorCount, dev);
        if (hipFuncSetAttribute((const void*)hybrid_fwd, hipFuncAttributeMaxDynamicSharedMemorySize, LDS_BYTES) != hipSuccess) { fprintf(stderr, "kernel_launch: hipFuncSetAttribute failed\n"); grid = -1; return; }
        if (hipOccupancyMaxActiveBlocksPerMultiprocessor(&per_cu, (const void*)hybrid_fwd, 512, LDS_BYTES) != hipSuccess || per_cu < 1) { fprintf(stderr, "kernel_launch: occupancy query says %d\n", per_cu); per_cu = 1; }
        (void)hipGetLastError();
        grid = cus;
    }
    if (grid < 0) return;
    (void)hipMemsetAsync((char*)d_ws + WS_BAR, 0, XCD_BAR_WORDS * 4, stream);
    Args a{};
    for (int i = 0; i < 27; ++i) a.in[i] = (const float*)d_in[i];
    a.out = (float*)d_out; a.ws = (unsigned char*)d_ws;
#if N_LAUNCH_PER_PHASE
    for (int ph = 0; ph < NPHASE; ++ph) { a.ph_lo = ph; a.ph_hi = ph + 1; hipLaunchKernelGGL(hybrid_fwd, dim3(grid), dim3(512), LDS_BYTES, stream, a); }
#else
    a.ph_lo = 0; a.ph_hi = NPHASE;
    void* args[] = {&a};
    hipError_t e = hipLaunchCooperativeKernel((const void*)hybrid_fwd, dim3(grid), dim3(512), args, LDS_BYTES, stream);
    if (e != hipSuccess) fprintf(stderr, "cooperative launch failed: %s (grid %d)\n", hipGetErrorString(e), grid);
#endif
}
```
